# Optimizing an MI355X kernel written in HIP

```python
import jax, jax.numpy as jnp
from jax import lax
import numpy as np

D_MODEL = 1024
BATCH = 16
SEQ = 2048
DEPTH = 2

HEAD_DIM = 64
DIFF_HEADS = 4
DIFF_QK_W = DIFF_HEADS * 2 * HEAD_DIM
DIFF_V_W = DIFF_HEADS * 2 * HEAD_DIM
DIL_HEADS = 8
DIL_W = DIL_HEADS * HEAD_DIM
DIL_PATTERNS = ((128, 1), (512, 4), (2048, 16))
HGRN_HEADS = 4
HGRN_DK = 128
HGRN_DV = 128
HGRN_K_W = HGRN_HEADS * HGRN_DK
HGRN_V_W = HGRN_HEADS * HGRN_DV
HGRN_CHUNK = 64
N_BRANCH = 3
D_FF = 2816
Q_BLOCK = 128
NORM_EPS = 1e-6
N_ALIBI = DIFF_HEADS + DIL_HEADS
ALIBI_A_IDX = (0, 3, 6, 9)
ALIBI_B_IDX = (1, 2, 4, 5, 7, 8, 10, 11)
IN_SIZES = (DIFF_QK_W, DIFF_QK_W, DIFF_V_W, DIL_W, DIL_W, DIL_W,
            HGRN_K_W, HGRN_K_W, HGRN_K_W, HGRN_V_W, HGRN_V_W, N_BRANCH * D_MODEL)
D_IN = sum(IN_SIZES)

kernel_name = "hybrid_diffattn_dilated_hgrn2_gated_encoder"


def rms_norm(x, g):
    xf = x.astype(jnp.float32)
    y = xf * lax.rsqrt(jnp.mean(xf * xf, axis=-1, keepdims=True) + NORM_EPS)
    return (y * g.astype(jnp.float32)).astype(x.dtype)


def swiglu(x, w_gate, w_up, w_down):
    return (jax.nn.silu(x @ w_gate) * (x @ w_up)) @ w_down


def alibi_slopes():
    h = jnp.arange(1, N_ALIBI + 1, dtype=jnp.float32)
    s = jnp.exp2(-8.0 * h / N_ALIBI)
    return s[jnp.array(ALIBI_A_IDX)], s[jnp.array(ALIBI_B_IDX)]


def split_columns(z):
    parts = []
    start = 0
    for size in IN_SIZES:
        parts.append(z[..., start:start + size])
        start += size
    return parts


def diff_attention(q, k, v, slopes, lam, subln, lam_init):
    B, S, H = q.shape[0], q.shape[1], q.shape[2]
    scale = HEAD_DIM ** -0.5
    qh = jnp.transpose(q, (0, 2, 3, 1, 4))
    kh = jnp.transpose(k, (0, 2, 3, 1, 4))
    vh = jnp.transpose(v, (0, 2, 1, 3))
    nblk = S // Q_BLOCK
    qb = jnp.moveaxis(qh.reshape(B, H, 2, nblk, Q_BLOCK, HEAD_DIM), 3, 0)
    kpos = jnp.arange(S)

    def block(args):
        qblk, bi = args
        qpos = bi * Q_BLOCK + jnp.arange(Q_BLOCK)
        dist = jnp.abs(qpos[:, None] - kpos[None, :]).astype(jnp.float32)
        bias = -slopes[:, None, None] * dist
        s = jnp.einsum('bhmqd,bhmkd->bhmqk', qblk, kh).astype(jnp.float32) * scale
        p = jax.nn.softmax(s + bias[None, :, None], axis=-1)
        pd = p[:, :, 0] - lam * p[:, :, 1]
        return jnp.einsum('bhqk,bhkv->bhqv', pd.astype(vh.dtype), vh)

    o = lax.map(block, (qb, jnp.arange(nblk)))
    o = jnp.moveaxis(o, 0, 2).reshape(B, H, S, 2 * HEAD_DIM)
    o = (rms_norm(o, subln) * (1.0 - lam_init)).astype(q.dtype)
    return jnp.transpose(o, (0, 2, 1, 3)).reshape(B, S, H * 2 * HEAD_DIM)


def dilated_pattern(q, k, v, slopes, window, dilation):
    B, H, S, dh = q.shape
    R = window // (2 * dilation)
    L = S // dilation
    nb = -(-L // R)
    Lp = nb * R
    scale = dh ** -0.5

    def to_sub(t):
        return jnp.swapaxes(t.reshape(B, H, L, dilation, dh), 2, 3)

    qs = jnp.pad(to_sub(q), ((0, 0), (0, 0), (0, 0), (0, Lp - L), (0, 0)))
    qs = qs.reshape(B, H, dilation, nb, R, dh)

    def band(t):
        tp = jnp.pad(to_sub(t), ((0, 0), (0, 0), (0, 0), (R, Lp - L + R), (0, 0)))
        tb = tp.reshape(B, H, dilation, nb + 2, R, dh)
        return jnp.concatenate([tb[:, :, :, :-2], tb[:, :, :, 1:-1], tb[:, :, :, 2:]], axis=4)

    kb, vb = band(k), band(v)
    qi = jnp.arange(nb)[:, None] * R + jnp.arange(R)[None, :]
    ki = jnp.arange(nb)[:, None] * R + jnp.arange(3 * R)[None, :] - R
    rel = jnp.abs(qi[:, :, None] - ki[:, None, :])
    valid = (rel <= R) & (ki[:, None, :] >= 0) & (ki[:, None, :] < L)
    bias = -slopes[:, None, None, None] * (rel * dilation).astype(jnp.float32)
    s = jnp.einsum('bhrnqd,bhrnkd->bhrnqk', qs, kb).astype(jnp.float32) * scale + bias[None, :, None]
    s = jnp.where(valid, s, -jnp.inf)
    lse = jax.nn.logsumexp(s, axis=-1)
    p = jnp.exp(s - lse[..., None])
    o = jnp.einsum('bhrnqk,bhrnkd->bhrnqd', p.astype(v.dtype), vb)
    o = o.reshape(B, H, dilation, Lp, dh)[:, :, :, :L]
    lse = lse.reshape(B, H, dilation, Lp)[:, :, :, :L]
    o = jnp.swapaxes(o, 2, 3).reshape(B, H, S, dh)
    lse = jnp.swapaxes(lse, 2, 3).reshape(B, H, S)
    return o, lse


def dilated_attention(q, k, v, slopes):
    B, S, _ = q.shape
    heads = lambda t: jnp.transpose(t.reshape(B, S, DIL_HEADS, HEAD_DIM), (0, 2, 1, 3))
    qh, kh, vh = heads(q), heads(k), heads(v)
    outs, lses = [], []
    for window, dilation in DIL_PATTERNS:
        o, lse = dilated_pattern(qh, kh, vh, slopes, window, dilation)
        outs.append(o)
        lses.append(lse)
    wts = jax.nn.softmax(jnp.stack(lses, axis=0), axis=0)
    o = jnp.einsum('pbhs,pbhsd->bhsd', wts, jnp.stack(outs, axis=0).astype(jnp.float32))
    return jnp.transpose(o, (0, 2, 1, 3)).reshape(B, S, DIL_W).astype(q.dtype)


def gla_chunk_scan(q, k, v, g):
    B, H, S, dk = q.shape
    dv = v.shape[-1]
    C = HGRN_CHUNK
    n = S // C
    chunks = lambda t: jnp.moveaxis(t.reshape(B, H, n, C, t.shape[-1]), 2, 0)
    causal = jnp.tril(jnp.ones((C, C), dtype=bool))

    def step(state, inp):
        qc, kc, vc, gc = inp
        bc = jnp.cumsum(gc, axis=2)
        o_inter = jnp.einsum('bhck,bhkv->bhcv', qc * jnp.exp(bc), state)
        diff = bc[:, :, :, None, :] - bc[:, :, None, :, :]
        decay = jnp.exp(jnp.where(causal[:, :, None], diff, -jnp.inf))
        a = jnp.einsum('bhtk,bhsk,bhtsk->bhts', qc, kc, decay)
        o_intra = jnp.einsum('bhts,bhsv->bhtv', a, vc)
        btot = bc[:, :, -1]
        state = jnp.exp(btot)[..., None] * state + jnp.einsum(
            'bhck,bhcv->bhkv', kc * jnp.exp(btot[:, :, None] - bc), vc)
        return state, o_inter + o_intra

    s0 = jnp.zeros((B, H, dk, dv), jnp.float32)
    _, o = lax.scan(step, s0, (chunks(q), chunks(k), chunks(v), chunks(g)))
    return jnp.moveaxis(o, 0, 2).reshape(B, H, S, dv)


def hgrn_direction(q, f_logit, i, lb):
    g = jnp.log(lb + (1.0 - lb) * jax.nn.sigmoid(f_logit))
    k = (1.0 - lb) * jax.nn.sigmoid(-f_logit)
    return gla_chunk_scan(q, k, i, g)


def hgrn2_mixer(q, f_fw, f_bw, i, og, lb, norm_g):
    B, S, _ = q.shape
    heads = lambda t, d: jnp.transpose(t.reshape(B, S, HGRN_HEADS, d), (0, 2, 1, 3)).astype(jnp.float32)
    qh, ih = heads(q, HGRN_DK), heads(i, HGRN_DV)
    ffh, fbh = heads(f_fw, HGRN_DK), heads(f_bw, HGRN_DK)
    lbh = lb.astype(jnp.float32).reshape(HGRN_HEADS, 1, HGRN_DK)
    o_fw = hgrn_direction(qh, ffh, ih, lbh)
    rev = lambda t: jnp.flip(t, axis=2)
    o_bw = rev(hgrn_direction(rev(qh), rev(fbh), rev(ih), lbh))
    o = rms_norm(o_fw + o_bw, norm_g) * jax.nn.silu(heads(og, HGRN_DV))
    return jnp.transpose(o, (0, 2, 1, 3)).reshape(B, S, HGRN_V_W).astype(q.dtype)


def setup_inputs(seed: int = 0) -> dict:
    key = jax.random.key(seed)
    ks = jax.random.split(key, 24)
    f32 = jnp.float32
    dense = lambda k, shape, fan_in: jax.random.normal(k, shape, f32) * fan_in ** -0.5
    gain = lambda k, shape: 1.0 + 0.02 * jax.random.normal(k, shape, f32)
    return {
        "x": jax.random.normal(ks[0], (BATCH, SEQ, D_MODEL), f32),
        "ffn1_norm": gain(ks[1], (DEPTH, D_MODEL)),
        "ffn1_w_gate": dense(ks[2], (DEPTH, D_MODEL, D_FF), D_MODEL),
        "ffn1_w_up": dense(ks[3], (DEPTH, D_MODEL, D_FF), D_MODEL),
        "ffn1_w_down": dense(ks[4], (DEPTH, D_FF, D_MODEL), D_FF),
        "mix_norm": gain(ks[5], (DEPTH, D_MODEL)),
        "w_in": dense(ks[6], (DEPTH, D_MODEL, D_IN), D_MODEL),
        "diff_lambda_q1": 0.1 * jax.random.normal(ks[7], (DEPTH, HEAD_DIM), f32),
        "diff_lambda_k1": 0.1 * jax.random.normal(ks[8], (DEPTH, HEAD_DIM), f32),
        "diff_lambda_q2": 0.1 * jax.random.normal(ks[9], (DEPTH, HEAD_DIM), f32),
        "diff_lambda_k2": 0.1 * jax.random.normal(ks[10], (DEPTH, HEAD_DIM), f32),
        "diff_subln": gain(ks[11], (DEPTH, 2 * HEAD_DIM)),
        "hgrn_lower_bounds": 0.1 * jax.random.normal(ks[12], (DEPTH, HGRN_K_W), f32),
        "hgrn_norm": gain(ks[13], (DEPTH, HGRN_DV)),
        "w_branch_a": dense(ks[14], (DEPTH, DIFF_V_W, D_MODEL), DIFF_V_W),
        "w_branch_b": dense(ks[15], (DEPTH, DIL_W, D_MODEL), DIL_W),
        "w_branch_c": dense(ks[16], (DEPTH, HGRN_V_W, D_MODEL), HGRN_V_W),
        "w_out": dense(ks[17], (DEPTH, D_MODEL, D_MODEL), D_MODEL),
        "ffn2_norm": gain(ks[18], (DEPTH, D_MODEL)),
        "ffn2_w_gate": dense(ks[19], (DEPTH, D_MODEL, D_FF), D_MODEL),
        "ffn2_w_up": dense(ks[20], (DEPTH, D_MODEL, D_FF), D_MODEL),
        "ffn2_w_down": dense(ks[21], (DEPTH, D_FF, D_MODEL), D_FF),
        "final_norm": gain(ks[22], (D_MODEL,)),
    }


def reference(x, ffn1_norm, ffn1_w_gate, ffn1_w_up, ffn1_w_down, mix_norm, w_in,
              diff_lambda_q1, diff_lambda_k1, diff_lambda_q2, diff_lambda_k2, diff_subln,
              hgrn_lower_bounds, hgrn_norm, w_branch_a, w_branch_b, w_branch_c, w_out,
              ffn2_norm, ffn2_w_gate, ffn2_w_up, ffn2_w_down, final_norm):
    B, S, _ = x.shape
    slopes_a, slopes_b = alibi_slopes()
    lb_p = jax.nn.softmax(hgrn_lower_bounds.astype(jnp.float32), axis=0)
    lb_all = jnp.cumsum(lb_p, axis=0) - lb_p[0]
    h = x
    for l in range(DEPTH):
        h = h + 0.5 * swiglu(rms_norm(h, ffn1_norm[l]), ffn1_w_gate[l], ffn1_w_up[l], ffn1_w_down[l])
        u = rms_norm(h, mix_norm[l])
        z = u @ w_in[l]
        a_q, a_k, a_v, b_q, b_k, b_v, c_q, c_ffw, c_fbw, c_i, c_og, gates = split_columns(z)
        lam_init = 0.8 - 0.6 * float(np.exp(-0.3 * l))
        lam = (jnp.exp(jnp.sum(diff_lambda_q1[l] * diff_lambda_k1[l]).astype(jnp.float32))
               - jnp.exp(jnp.sum(diff_lambda_q2[l] * diff_lambda_k2[l]).astype(jnp.float32)) + lam_init)
        ya = diff_attention(a_q.reshape(B, S, DIFF_HEADS, 2, HEAD_DIM),
                            a_k.reshape(B, S, DIFF_HEADS, 2, HEAD_DIM),
                            a_v.reshape(B, S, DIFF_HEADS, 2 * HEAD_DIM),
                            slopes_a, lam, diff_subln[l], lam_init)
        yb = dilated_attention(b_q, b_k, b_v, slopes_b)
        yc = hgrn2_mixer(c_q, c_ffw, c_fbw, c_i, c_og, lb_all[l], hgrn_norm[l])
        g = jax.nn.sigmoid(gates.astype(jnp.float32)).reshape(B, S, N_BRANCH, D_MODEL).astype(h.dtype)
        merged = (g[:, :, 0] * (ya @ w_branch_a[l]) + g[:, :, 1] * (yb @ w_branch_b[l])
                  + g[:, :, 2] * (yc @ w_branch_c[l]))
        h = h + merged @ w_out[l]
        h = h + 0.5 * swiglu(rms_norm(h, ffn2_norm[l]), ffn2_w_gate[l], ffn2_w_up[l], ffn2_w_down[l])
    return rms_norm(h, final_norm)
```

```cpp
#include <hip/hip_runtime.h>
#include <hip/hip_cooperative_groups.h>
#include <cstdio>
#include <cstdint>
namespace cg = cooperative_groups;

#define LAS __attribute__((address_space(3)))
typedef unsigned short bf16_t;
typedef short bf16x8 __attribute__((ext_vector_type(8)));
typedef short s16x4 __attribute__((ext_vector_type(4)));
typedef short v4i16_t __attribute__((ext_vector_type(4)));
typedef float f32x4 __attribute__((ext_vector_type(4)));
typedef float f32x2 __attribute__((ext_vector_type(2)));
typedef unsigned u32x4 __attribute__((ext_vector_type(4)));
typedef unsigned u32x2 __attribute__((ext_vector_type(2)));
typedef __bf16 bf16x2_t __attribute__((ext_vector_type(2)));

#define LOG2E 1.4426950408889634f
#define LN2F 0.6931471805599453f
#define QSCALE 0.18033688011112042f

__device__ __forceinline__ unsigned pk2(float lo, float hi) { f32x2 v = {lo, hi}; bf16x2_t b = __builtin_convertvector(v, bf16x2_t); return __builtin_bit_cast(unsigned, b); }
__device__ __forceinline__ unsigned short f2bf(float f) { return (unsigned short)(pk2(f, 0.f) & 0xffffu); }
__device__ __forceinline__ float bf2f(unsigned short h) { return __uint_as_float(((unsigned)h) << 16); }
__device__ __forceinline__ float bflo(unsigned w) { return __uint_as_float(w << 16); }
__device__ __forceinline__ float bfhi(unsigned w) { return __uint_as_float(w & 0xffff0000u); }
__device__ __forceinline__ float fexp2(float x) { return __builtin_amdgcn_exp2f(x); }
__device__ __forceinline__ float flog2(float x) { return __builtin_amdgcn_logf(x); }
__device__ __forceinline__ float frcp(float x) { return __builtin_amdgcn_rcpf(x); }
__device__ __forceinline__ float sigmoidf_(float x) { return frcp(1.f + fexp2(-LOG2E * x)); }
__device__ __forceinline__ float siluf_(float x) { return x * frcp(1.f + fexp2(-LOG2E * x)); }
__device__ __forceinline__ f32x4 mfma16(bf16x8 a, bf16x8 b, f32x4 c) { return __builtin_amdgcn_mfma_f32_16x16x32_bf16(a, b, c, 0, 0, 0); }
__device__ __forceinline__ s16x4 ldtr(const LAS unsigned char* p) { return __builtin_bit_cast(s16x4, __builtin_amdgcn_ds_read_tr16_b64_v4i16((LAS v4i16_t*)p)); }
__device__ __forceinline__ bf16x8 cat8(s16x4 a, s16x4 b) { bf16x8 r; r[0] = a[0]; r[1] = a[1]; r[2] = a[2]; r[3] = a[3]; r[4] = b[0]; r[5] = b[1]; r[6] = b[2]; r[7] = b[3]; return r; }
__device__ __forceinline__ bf16x8 pack8(f32x4 a, f32x4 b) { u32x4 w; w.x = pk2(a[0], a[1]); w.y = pk2(a[2], a[3]); w.z = pk2(b[0], b[1]); w.w = pk2(b[2], b[3]); return __builtin_bit_cast(bf16x8, w); }
__device__ __forceinline__ float wave_sum(float v) {
#pragma unroll
    for (int o = 1; o < 64; o <<= 1) v += __shfl_xor(v, o);
    return v;
}

namespace pg8 {
#define PG8_LAS __attribute__((address_space(3)))
typedef unsigned short bf16_t;
typedef short bf16x8 __attribute__((ext_vector_type(8)));
typedef float f32x4 __attribute__((ext_vector_type(4)));
typedef unsigned u32x4 __attribute__((ext_vector_type(4)));
constexpr int BM = 256, BK = 64, HALF = 128, HTB = HALF * BK * 2  , STAGE_BYTES = 8 * HTB, NXCD = 8, WGM = 4;

__host__ __device__ __forceinline__ int lds_byte(int r, int c) { const int st = (r >> 4) * 2 + (c >> 5), rr = r & 15, cc = c & 31, ob = rr * 64 + cc * 2; return st * 1024 + (ob ^ (((ob >> 9) & 1) << 5)); }
__host__ __device__ __forceinline__ void stage_rc(int b, int& R, int& C) { const int st = b / 1024, sb = b % 1024, swz = sb ^ (((sb >> 9) & 1) << 5); R = (st >> 1) * 16 + swz / 64; C = (st & 1) * 32 + (swz % 64) / 2; }
__host__ __device__ __forceinline__ int perm32(int rho) { const int n = rho >> 4, i = rho & 15; return 8 * (i >> 2) + 4 * n + (i & 3); }

struct Unit { int pm, pn; };
struct Gemm { const bf16_t* A; const bf16_t* Bt; int M, N, K; };

struct StaticOrder {
    int nM, nN, nwg, G, c;
    __host__ __device__ void init(int M, int N, int G_, int c_) { nM = M / BM; nN = N / BM; nwg = nM * nN; G = G_; c = c_; }
    __host__ __device__ bool next(int i, Unit& u) const {
        const long L = (long)i * G + c; if (L >= nwg) return false;
        int wgid = (int)L; { const int q = nwg / NXCD, r = nwg % NXCD, xcd = wgid % NXCD, off = wgid / NXCD; wgid = (xcd < r ? xcd * (q + 1) : r * (q + 1) + (xcd - r) * q) + off; }
        const int nig = WGM * nN, gid = wgid / nig, fm = gid * WGM, gsz = (nM - fm) < WGM ? (nM - fm) : WGM;
        u.pm = fm + ((wgid % nig) % gsz); u.pn = (wgid % nig) / gsz; return true;
    }
    __device__ __forceinline__ void a_ready(const Unit&) const {}
    __device__ __forceinline__ void done(const Unit&) const {}
};

typedef unsigned u32x2v __attribute__((ext_vector_type(2)));
struct EpiGU {
    static constexpr bool PERM = true, AFTER_DRAIN = false, HOOK = false;
    bf16_t* O; int ldo; const unsigned* RS;
    __device__ __forceinline__ void operator()(const f32x4 (&acc)[2][2][4][2], const Unit& u, int wr, int wc, int fr, int fq) const {
        const int row0 = u.pm * BM + wr * 64 + fr, col0 = u.pn * 128 + wc * 32 + 8 * fq;
        float rsv[2][4];
#pragma unroll
        for (int ai = 0; ai < 2; ++ai)
#pragma unroll
            for (int m = 0; m < 4; ++m) rsv[ai][m] = (float)RS[row0 + ai * HALF + m * 16] * (1.f / 1024.f);
#pragma unroll
        for (int ai = 0; ai < 2; ++ai)
#pragma unroll
            for (int mp = 0; mp < 2; ++mp) {
                float g[16], uu[16], e[16];
#pragma unroll
                for (int h = 0; h < 2; ++h) {
                    const int m = 2 * mp + h;
                    const float rs = __builtin_amdgcn_rsqf(rsv[ai][m] * (1.f / 1024.f) + 1e-6f);
#pragma unroll
                    for (int j = 0; j < 4; ++j) { g[8 * h + j] = acc[ai][0][m][0][j] * rs; g[8 * h + 4 + j] = acc[ai][0][m][1][j] * rs; uu[8 * h + j] = acc[ai][1][m][0][j] * rs; uu[8 * h + 4 + j] = acc[ai][1][m][1][j] * rs; }
                }
                __builtin_amdgcn_sched_barrier(0);
#pragma unroll
                for (int i = 0; i < 16; ++i) e[i] = ::fexp2(-LOG2E * g[i]);
                __builtin_amdgcn_sched_barrier(0);
#pragma unroll
                for (int i = 0; i < 16; ++i) e[i] = ::frcp(1.f + e[i]);
                __builtin_amdgcn_sched_barrier(0);
#pragma unroll
                for (int i = 0; i < 16; ++i) g[i] = g[i] * e[i] * uu[i];
#pragma unroll
                for (int h = 0; h < 2; ++h) {
                    bf16_t* rowp = O + (size_t)(row0 + ai * HALF + (2 * mp + h) * 16) * ldo + col0;
                    u32x4 w; w.x = ::pk2(g[8 * h + 0], g[8 * h + 1]); w.y = ::pk2(g[8 * h + 2], g[8 * h + 3]); w.z = ::pk2(g[8 * h + 4], g[8 * h + 5]); w.w = ::pk2(g[8 * h + 6], g[8 * h + 7]);
                    *(u32x4*)rowp = w;
                }
            }
    }
};
struct EpiRes {
    static constexpr bool PERM = true, AFTER_DRAIN = false, HOOK = false;
    const float* Rf; bf16_t* X; unsigned* RS; long long half_;
    __device__ __forceinline__ void operator()(const f32x4 (&acc)[2][2][4][2], const Unit& u, int wr, int wc, int fr, int fq) const {
        const int row0 = u.pm * BM + wr * 64 + fr, col0 = u.pn * BM + wc * 32 + 8 * fq;
        const float* const Rf = this->Rf; bf16_t* const X = this->X; const float scale = this->half_ ? 0.5f : 1.0f; unsigned* const RS = this->RS;
        f32x4 rv[2][2], rn[2][2];
#define EPIRES_LOAD(dst, off_) do { _Pragma("unroll") for (int bj = 0; bj < 2; ++bj) { const size_t p_ = (off_) + bj * HALF; \
            if (Rf) { dst[bj][0] = *(const f32x4*)(Rf + p_); dst[bj][1] = *(const f32x4*)(Rf + p_ + 4); } \
            else { const u32x4 w_ = *(const u32x4*)(X + p_); dst[bj][0] = (f32x4){::bflo(w_.x), ::bfhi(w_.x), ::bflo(w_.y), ::bfhi(w_.y)}; dst[bj][1] = (f32x4){::bflo(w_.z), ::bfhi(w_.z), ::bflo(w_.w), ::bfhi(w_.w)}; } } } while (0)
        EPIRES_LOAD(rv, (size_t)row0 * 1024 + col0);
#pragma unroll
        for (int b = 0; b < 8; ++b) {
            const int ai = b >> 2, m = b & 3;
            const size_t off = (size_t)(row0 + ai * HALF + m * 16) * 1024 + col0;
            if (b < 7) EPIRES_LOAD(rn, (size_t)(row0 + ((b + 1) >> 2) * HALF + ((b + 1) & 3) * 16) * 1024 + col0);
            float ss = 0.f;
#pragma unroll
            for (int bj = 0; bj < 2; ++bj) {
                const f32x4 o0 = rv[bj][0] + acc[ai][bj][m][0] * scale, o1 = rv[bj][1] + acc[ai][bj][m][1] * scale;
                u32x4 w; w.x = ::pk2(o0[0], o0[1]); w.y = ::pk2(o0[2], o0[3]); w.z = ::pk2(o1[0], o1[1]); w.w = ::pk2(o1[2], o1[3]);
                *(u32x4*)(X + off + bj * HALF) = w;
                const float q0 = ::bflo(w.x), q1 = ::bfhi(w.x), q2 = ::bflo(w.y), q3 = ::bfhi(w.y), q4 = ::bflo(w.z), q5 = ::bfhi(w.z), q6 = ::bflo(w.w), q7 = ::bfhi(w.w);
                ss += ((q0 * q0 + q1 * q1) + (q2 * q2 + q3 * q3)) + ((q4 * q4 + q5 * q5) + (q6 * q6 + q7 * q7));
            }
            ss += __shfl_xor(ss, 16); ss += __shfl_xor(ss, 32);
            if (fq == 0) atomicAdd(RS + row0 + ai * HALF + m * 16, (unsigned)(ss * 1024.f + 0.5f));
#pragma unroll
            for (int bj = 0; bj < 2; ++bj)
#pragma unroll
                for (int n = 0; n < 2; ++n) rv[bj][n] = rn[bj][n];
        }
#undef EPIRES_LOAD
    }
};
struct EpiIn {
    static constexpr bool PERM = true, AFTER_DRAIN = false, HOOK = false;
    bf16_t *zA, *zB, *zC, *zG; const unsigned* RS;
    __device__ __forceinline__ void operator()(const f32x4 (&acc)[2][2][4][2], const Unit& u, int wr, int wc, int fr, int fq) const {
        const int pn = u.pn; bf16_t* base; int ld, ct; float sc = 1.f; bool sig = false;
        if (pn < 6) { base = zA; ld = 1536; ct = pn; if (ct < 2) sc = QSCALE; }
        else if (pn < 12) { base = zB; ld = 1536; ct = pn - 6; if (ct < 2) sc = QSCALE; }
        else if (pn < 22) { base = zC; ld = 2560; ct = pn - 12; }
        else { base = zG; ld = 3072; ct = pn - 22; sig = true; }
        const int row0 = u.pm * BM + wr * 64 + fr, col0 = ct * BM + wc * 32 + 8 * fq;
        float rsv[2][4];
#pragma unroll
        for (int ai = 0; ai < 2; ++ai)
#pragma unroll
            for (int m = 0; m < 4; ++m) rsv[ai][m] = (float)RS[row0 + ai * HALF + m * 16] * (1.f / 1024.f);
#pragma unroll
        for (int ai = 0; ai < 2; ++ai)
#pragma unroll
            for (int m = 0; m < 4; ++m) {
                bf16_t* rowp = base + (size_t)(row0 + ai * HALF + m * 16) * ld + col0;
                const float rs = __builtin_amdgcn_rsqf(rsv[ai][m] * (1.f / 1024.f) + 1e-6f);
#pragma unroll
                for (int bj = 0; bj < 2; ++bj) {
                    f32x4 v0 = acc[ai][bj][m][0] * rs, v1 = acc[ai][bj][m][1] * rs;
                    if (sig) {
                        float e[8];
                        __builtin_amdgcn_sched_barrier(0);
#pragma unroll
                        for (int j = 0; j < 4; ++j) { e[j] = ::fexp2(-LOG2E * v0[j]); e[4 + j] = ::fexp2(-LOG2E * v1[j]); }
                        __builtin_amdgcn_sched_barrier(0);
#pragma unroll
                        for (int j = 0; j < 8; ++j) e[j] = ::frcp(1.f + e[j]);
                        __builtin_amdgcn_sched_barrier(0);
#pragma unroll
                        for (int j = 0; j < 4; ++j) { v0[j] = e[j]; v1[j] = e[4 + j]; }
                    } else { v0 = v0 * sc; v1 = v1 * sc; }
                    u32x4 w; w.x = ::pk2(v0[0], v0[1]); w.y = ::pk2(v0[2], v0[3]); w.z = ::pk2(v1[0], v1[1]); w.w = ::pk2(v1[2], v1[3]);
                    *(u32x4*)(rowp + bj * HALF) = w;
                }
            }
    }
};
struct EpiBr {
    static constexpr bool PERM = true, AFTER_DRAIN = false, HOOK = true;
    const bf16_t* G; bf16_t* Bo;
    static __device__ __forceinline__ void unpack8(u32x4 w, f32x4& a, f32x4& b) { a = (f32x4){::bflo(w.x), ::bfhi(w.x), ::bflo(w.y), ::bfhi(w.y)}; b = (f32x4){::bflo(w.z), ::bfhi(w.z), ::bflo(w.w), ::bfhi(w.w)}; }
    __device__ __forceinline__ void mid(f32x4 (&acc)[2][2][4][2], const Unit& u, int seg, int wr, int wc, int fr, int fq) const {
        const int row0 = u.pm * BM + wr * 64 + fr, col0 = u.pn * BM + wc * 32 + 8 * fq;
        const bf16_t* const Gn = G + (seg - 1) * 1024;
#pragma unroll
        for (int ai = 0; ai < 2; ++ai)
#pragma unroll
            for (int m = 0; m < 4; ++m) {
                const size_t r = (size_t)(row0 + ai * HALF + m * 16);
                u32x4 gn[2], gd[2];
#pragma unroll
                for (int bj = 0; bj < 2; ++bj) { gn[bj] = *(const u32x4*)(Gn + r * 3072 + col0 + bj * HALF); gd[bj] = *(const u32x4*)(Gn + r * 3072 + 1024 + col0 + bj * HALF); }
                f32x4 rt[2][2];
                __builtin_amdgcn_sched_barrier(0);
#pragma unroll
                for (int bj = 0; bj < 2; ++bj) {
                    f32x4 a0, a1, d0, d1; unpack8(gn[bj], a0, a1); unpack8(gd[bj], d0, d1);
#pragma unroll
                    for (int j = 0; j < 4; ++j) { rt[bj][0][j] = fmaxf(a0[j], 1e-30f) * ::frcp(fmaxf(d0[j], 1e-30f)); rt[bj][1][j] = fmaxf(a1[j], 1e-30f) * ::frcp(fmaxf(d1[j], 1e-30f)); }
                }
                __builtin_amdgcn_sched_barrier(0);
#pragma unroll
                for (int bj = 0; bj < 2; ++bj) { acc[ai][bj][m][0] = acc[ai][bj][m][0] * rt[bj][0]; acc[ai][bj][m][1] = acc[ai][bj][m][1] * rt[bj][1]; }
            }
    }
    __device__ __forceinline__ void operator()(const f32x4 (&acc)[2][2][4][2], const Unit& u, int wr, int wc, int fr, int fq) const {
        const int row0 = u.pm * BM + wr * 64 + fr, col0 = u.pn * BM + wc * 32 + 8 * fq;
#pragma unroll
        for (int ai = 0; ai < 2; ++ai)
#pragma unroll
            for (int m = 0; m < 4; ++m) {
                const size_t r = (size_t)(row0 + ai * HALF + m * 16);
                u32x4 gv[2];
#pragma unroll
                for (int bj = 0; bj < 2; ++bj) gv[bj] = *(const u32x4*)(G + r * 3072 + 2048 + col0 + bj * HALF);
#pragma unroll
                for (int bj = 0; bj < 2; ++bj) {
                    f32x4 g0, g1; unpack8(gv[bj], g0, g1);
                    f32x4 v0 = acc[ai][bj][m][0], v1 = acc[ai][bj][m][1];
#pragma unroll
                    for (int j = 0; j < 4; ++j) { v0[j] *= fmaxf(g0[j], 1e-30f); v1[j] *= fmaxf(g1[j], 1e-30f); }
                    u32x4 w; w.x = ::pk2(v0[0], v0[1]); w.y = ::pk2(v0[2], v0[3]); w.z = ::pk2(v1[0], v1[1]); w.w = ::pk2(v1[2], v1[3]);
                    *(u32x4*)(Bo + r * 1024 + col0 + bj * HALF) = w;
                }
            }
    }
};
template <class Epi, class Sched, bool ALIGN_EPI = false, bool SP2 = false>
__device__ __forceinline__ void gemm_phase(PG8_LAS unsigned char* lds, const Gemm g, const Sched& S, const Epi& E) {
    int tid_l = threadIdx.x; asm volatile("" : "+v"(tid_l)); const int tid = tid_l, wid = __builtin_amdgcn_readfirstlane(tid >> 6), lane = tid & 63, wr = wid >> 2, wc = wid & 3, fr = lane & 15, fq = lane >> 4;
    const int K = g.K, nt = K / BK;
    unsigned voffA[2], voffB[2];
#pragma unroll
    for (int i = 0; i < 2; ++i) { int R, C; stage_rc(tid * 16 + i * 8192, R, C); const int Rb = Epi::PERM ? ((R & ~31) + perm32(R & 31)) : R;
        voffA[i] = (unsigned)(R * K + C) * 2u; voffB[i] = (unsigned)(Rb * K + C) * 2u; }
    const size_t kstep = (size_t)(BK * 2);
    const size_t hstep = (size_t)HALF * K * 2;
    const size_t tstep = 2 * hstep;
    const unsigned ldsw = (unsigned)wid * 1024u;
    const int aoff = lds_byte(wr * 64 + fr, fq * 8), boff = lds_byte(wc * 32 + fr, fq * 8);
#define PG8_SA(b, h) (((b) * 2 + (h)) * HTB)
#define PG8_SB(b, h) ((4 + (b) * 2 + (h)) * HTB)
#define PG8_STAGE(bufoff, gbase, voff) do { _Pragma("unroll") for (int _i = 0; _i < 2; ++_i) \
        __builtin_amdgcn_global_load_lds((const unsigned*)((const char*)(gbase) + (voff)[_i]), (PG8_LAS unsigned*)(lds + (bufoff) + ldsw + _i * 8192), 16, 0, 0); } while (0)
#define PG8_LDA(dst, b, h) do { _Pragma("unroll") for (int m = 0; m < 4; ++m) _Pragma("unroll") for (int k = 0; k < 2; ++k) dst[m][k] = *(const PG8_LAS bf16x8*)(lds + PG8_SA(b, h) + aoff + m * 2048 + k * 1024); } while (0)
#define PG8_LDB(dst, b, h) do { _Pragma("unroll") for (int n = 0; n < 2; ++n) _Pragma("unroll") for (int k = 0; k < 2; ++k) dst[n][k] = *(const PG8_LAS bf16x8*)(lds + PG8_SB(b, h) + boff + n * 2048 + k * 1024); } while (0)
#define PG8_MMA(ai, bj, At, Bt) do { __builtin_amdgcn_s_setprio(1); _Pragma("unroll") for (int m = 0; m < 4; ++m) _Pragma("unroll") for (int n = 0; n < 2; ++n) _Pragma("unroll") for (int k = 0; k < 2; ++k) \
        acc[ai][bj][m][n] = __builtin_amdgcn_mfma_f32_16x16x32_bf16(Bt[n][k], At[m][k], acc[ai][bj][m][n], 0, 0, 0); __builtin_amdgcn_s_setprio(0); } while (0)
#define PG8_WAIT_V(n) asm volatile("s_waitcnt vmcnt(" #n ")" ::: "memory")
#define PG8_WAIT_L(n) asm volatile("s_waitcnt lgkmcnt(" #n ")" ::: "memory")
#define PG8_BAR __builtin_amdgcn_s_barrier()
#define PG8_SCHED __builtin_amdgcn_sched_barrier(0)
    Unit cur, nxt; int ui = 0;
    if (!S.next(0, cur)) return;
    f32x4 acc[2][2][4][2];
#pragma unroll
    for (int a = 0; a < 2; ++a)
#pragma unroll
        for (int b = 0; b < 2; ++b)
#pragma unroll
            for (int m = 0; m < 4; ++m)
#pragma unroll
                for (int n = 0; n < 2; ++n) acc[a][b][m][n] = (f32x4){0.f, 0.f, 0.f, 0.f};
    bf16x8 At[4][2], B0[2][2], B1[2][2];
    const char* cA = (const char*)g.A + (size_t)cur.pm * tstep; const char* cB = (const char*)g.Bt + (size_t)cur.pn * tstep;
    S.a_ready(cur);
    if constexpr (SP2) {
        PG8_STAGE(PG8_SB(0, 0), cB, voffB); PG8_STAGE(PG8_SB(0, 1), cB + hstep, voffB); PG8_STAGE(PG8_SA(0, 0), cA, voffA); PG8_STAGE(PG8_SA(0, 1), cA + hstep, voffA);
        if (wr == 1) PG8_BAR;
        PG8_WAIT_V(2); PG8_BAR;
        PG8_STAGE(PG8_SB(1, 0), cB + kstep, voffB); PG8_STAGE(PG8_SA(1, 0), cA + kstep, voffA); PG8_STAGE(PG8_SB(1, 1), cB + hstep + kstep, voffB);
        PG8_WAIT_V(6); PG8_BAR;
    } else {
        PG8_STAGE(PG8_SB(0, 0), cB, voffB); PG8_STAGE(PG8_SA(0, 0), cA, voffA); PG8_STAGE(PG8_SB(0, 1), cB + hstep, voffB); PG8_STAGE(PG8_SA(0, 1), cA + hstep, voffA);
        if (wr == 1) PG8_BAR;
        PG8_WAIT_V(4); PG8_BAR;
        PG8_STAGE(PG8_SB(1, 0), cB + kstep, voffB); PG8_STAGE(PG8_SA(1, 0), cA + kstep, voffA); PG8_STAGE(PG8_SB(1, 1), cB + hstep + kstep, voffB);
        PG8_WAIT_V(6); PG8_BAR;
    }
    for (;;) {
        const bool has_next = S.next(ui + 1, nxt);
        const char* nA = has_next ? (const char*)g.A + (size_t)nxt.pm * tstep : cA; const char* nB = has_next ? (const char*)g.Bt + (size_t)nxt.pn * tstep : cB;
        for (int t = 0; t < nt; t += 2) {
            if constexpr (Epi::HOOK) { if (t == 8 || t == 16) E.mid(acc, cur, t >> 3, wr, wc, fr, fq); }
            const bool last = (t == nt - 2);
            const char* a1 = cA + (size_t)(t + 1) * kstep;
            const char* a2 = last ? nA : cA + (size_t)(t + 2) * kstep; const char* b2 = last ? nB : cB + (size_t)(t + 2) * kstep;
            const char* a3 = a2 + kstep; const char* b3 = b2 + kstep;
            if (last && has_next) S.a_ready(nxt);
            if constexpr (SP2) {
            PG8_LDB(B0, 0, 0); PG8_LDB(B1, 0, 1); PG8_SCHED; PG8_LDA(At, 0, 0); PG8_STAGE(PG8_SA(1, 1), a1 + hstep, voffA);
            PG8_WAIT_V(8); PG8_WAIT_L(0); PG8_BAR; PG8_MMA(0, 0, At, B0); PG8_MMA(0, 1, At, B1); PG8_BAR; PG8_SCHED;
            PG8_LDA(At, 0, 1); PG8_STAGE(PG8_SB(0, 0), b2, voffB); PG8_STAGE(PG8_SB(0, 1), b2 + hstep, voffB); PG8_STAGE(PG8_SA(0, 0), a2, voffA);
            PG8_WAIT_V(8); PG8_WAIT_L(0); PG8_BAR; PG8_MMA(1, 0, At, B0); PG8_MMA(1, 1, At, B1); PG8_BAR; PG8_SCHED;
            PG8_LDB(B0, 1, 0); PG8_LDB(B1, 1, 1); PG8_SCHED; PG8_LDA(At, 1, 0); PG8_STAGE(PG8_SA(0, 1), a2 + hstep, voffA);
            PG8_WAIT_V(8); PG8_WAIT_L(0); PG8_BAR; PG8_MMA(0, 0, At, B0); PG8_MMA(0, 1, At, B1); PG8_BAR; PG8_SCHED;
            PG8_LDA(At, 1, 1); PG8_STAGE(PG8_SB(1, 0), b3, voffB); PG8_STAGE(PG8_SB(1, 1), b3 + hstep, voffB); PG8_STAGE(PG8_SA(1, 0), a3, voffA);
            PG8_WAIT_V(8); PG8_WAIT_L(0); PG8_BAR; PG8_MMA(1, 0, At, B0); PG8_MMA(1, 1, At, B1); PG8_BAR; PG8_SCHED;
            } else {
            PG8_LDB(B0, 0, 0); PG8_SCHED; PG8_LDA(At, 0, 0); PG8_STAGE(PG8_SA(1, 1), a1 + hstep, voffA);
            PG8_WAIT_L(8); PG8_BAR; PG8_WAIT_L(0); PG8_MMA(0, 0, At, B0); PG8_BAR; PG8_SCHED;
            PG8_LDB(B1, 0, 1); PG8_STAGE(PG8_SB(0, 0), b2, voffB);
            PG8_BAR; PG8_WAIT_L(0); PG8_MMA(0, 1, At, B1); PG8_BAR;
            PG8_LDA(At, 0, 1); PG8_STAGE(PG8_SA(0, 0), a2, voffA);
            PG8_BAR; PG8_WAIT_L(0); PG8_MMA(1, 0, At, B0); PG8_BAR; PG8_SCHED;
            PG8_STAGE(PG8_SB(0, 1), b2 + hstep, voffB);
            PG8_WAIT_V(6); PG8_BAR; PG8_MMA(1, 1, At, B1); PG8_BAR;
            PG8_LDB(B0, 1, 0); PG8_SCHED; PG8_LDA(At, 1, 0); PG8_STAGE(PG8_SA(0, 1), a2 + hstep, voffA);
            PG8_WAIT_L(8); PG8_BAR; PG8_WAIT_L(0); PG8_MMA(0, 0, At, B0); PG8_BAR; PG8_SCHED;
            PG8_LDB(B1, 1, 1); PG8_STAGE(PG8_SB(1, 0), b3, voffB);
            PG8_BAR; PG8_WAIT_L(0); PG8_MMA(0, 1, At, B1); PG8_BAR;
            PG8_LDA(At, 1, 1); PG8_STAGE(PG8_SA(1, 0), a3, voffA);
            PG8_BAR; PG8_WAIT_L(0); PG8_MMA(1, 0, At, B0); PG8_BAR; PG8_SCHED;
            PG8_STAGE(PG8_SB(1, 1), b3 + hstep, voffB);
            PG8_WAIT_V(6); PG8_BAR; PG8_MMA(1, 1, At, B1); PG8_BAR;
            }
        }
        if constexpr (ALIGN_EPI) { if (wr == 0) PG8_BAR; }
        if constexpr (!Epi::AFTER_DRAIN) { E(acc, cur, wr, wc, fr, fq); S.done(cur); }
        if (!has_next) break;
#pragma unroll
        for (int a = 0; a < 2; ++a)
#pragma unroll
            for (int b = 0; b < 2; ++b)
#pragma unroll
                for (int m = 0; m < 4; ++m)
#pragma unroll
                    for (int n = 0; n < 2; ++n) acc[a][b][m][n] = (f32x4){0.f, 0.f, 0.f, 0.f};
        cur = nxt; cA = nA; cB = nB; ++ui;
        if constexpr (ALIGN_EPI) { if (wr == 1) PG8_BAR; }
    }
    PG8_WAIT_V(0);
    if constexpr (!ALIGN_EPI) { if (wr == 0) PG8_BAR; }
    PG8_BAR;
    if constexpr (Epi::AFTER_DRAIN) { E.fused(acc, cur, wr, wc, fr, fq, lds, wid, lane); S.done(cur); }
#undef PG8_SA
#undef PG8_SB
#undef PG8_STAGE
#undef PG8_LDA
#undef PG8_LDB
#undef PG8_MMA
#undef PG8_WAIT_V
#undef PG8_WAIT_L
#undef PG8_BAR
#undef PG8_SCHED
}
}

constexpr int SEQ = 2048, NBATCH = 16, MTOK = NBATCH * SEQ, DM = 1024, DFF = 2816, DIN = 8704, MH = MTOK / 2, NBH = NBATCH / 2;
constexpr size_t MiB = 1u << 20;
constexpr size_t WS_CTL = 0, CTL_BYTES = 1u << 20, WS_RS = 65536;
constexpr int CW_BAR = 1024;
constexpr size_t WS_W = 1 * MiB;
constexpr size_t W_GU1 = 0, W_D1 = 11 * MiB, W_IN = W_D1 + 5767168, W_BA = W_IN + 17 * MiB, W_BB = W_BA + MiB, W_BC = W_BB + MiB, W_OUT = W_BC + MiB, W_GU2 = W_OUT + 2 * MiB, W_D2 = W_GU2 + 11 * MiB;
constexpr size_t WS_XN = 56 * MiB, WS_BIG = 120 * MiB;
constexpr size_t WS_ZA = WS_BIG, WS_ZB = WS_ZA + 48 * MiB, WS_ZC = WS_ZB + 48 * MiB, WS_ZG = WS_ZC + 80 * MiB;
constexpr size_t WS_MF = WS_BIG, WS_MB = WS_BIG + 64 * MiB;
constexpr size_t WS_YA = 392 * MiB, WS_YB = 408 * MiB, WS_YC = 424 * MiB, WS_OP = 440 * MiB, WS_LSE = 488 * MiB, WS_END = 490 * MiB;
static_assert(W_D2 + 5767168 <= 55 * MiB, "weights map");
constexpr int LDS_BYTES = 147456, LDS_CTRL = 140000;
constexpr int NPH = 35;
constexpr int NU_H = NBH * 4 * 2, NU_D = NBH * 4 * 16, NU_L = NBH * 8 * 3 * 4, NU_ALL = NU_H + NU_D + NU_L;

#ifndef PROBE_DUP_H
#define PROBE_DUP_H 0
#endif
#ifndef PROBE_DUP_A
#define PROBE_DUP_A 0
#endif
struct Args { const float* in[23]; float* out; unsigned char* ws; int ph_lo, ph_hi; };
typedef const __attribute__((address_space(4))) Args* ArgP;

__device__ __forceinline__ void transpose_item(const float* W, int N, int K, bf16_t* WT, const float* gain, int drow0, int k0, int n0, LAS float* scr, int lane, int ldk = 0, int koff = 0) {
    if (ldk == 0) ldk = K;
    const int c4 = lane & 15, kr = lane >> 4;
#pragma unroll 8
    for (int i = 0; i < 16; ++i) { const int kk = 4 * i + kr; const float gs = gain ? gain[k0 + kk] : 1.f; const f32x4 v = *(const f32x4*)(W + (size_t)(k0 + kk) * N + n0 + 4 * c4); *(LAS f32x4*)(scr + kk * 68 + 4 * c4) = v * gs; }
    asm volatile("s_waitcnt lgkmcnt(0)" ::: "memory");
    const int c = lane & 7;
#pragma unroll
    for (int j = 0; j < 8; ++j) { const int n = (lane >> 3) + 8 * j; const LAS float* s = scr + (8 * c) * 68 + n;
        u32x4 o; o.x = pk2(s[0 * 68], s[1 * 68]); o.y = pk2(s[2 * 68], s[3 * 68]); o.z = pk2(s[4 * 68], s[5 * 68]); o.w = pk2(s[6 * 68], s[7 * 68]);
        *(u32x4*)(WT + (size_t)(drow0 + n) * ldk + koff + k0 + 8 * c) = o; }
    asm volatile("s_waitcnt lgkmcnt(0)" ::: "memory");
}
__device__ __forceinline__ void tr_plain(const float* W, int K, int N, bf16_t* WT, const float* gain, int item, LAS float* scr, int lane, int ldk = 0, int koff = 0) {
    const int nblk = N / 64, kb = item / nblk, nb = item % nblk;
    transpose_item(W, N, K, WT, gain, nb * 64, kb * 64, nb * 64, scr, lane, ldk, koff);
}
__device__ __forceinline__ void tr_gu(const float* W, bf16_t* WT, const float* gain, int up, int item, LAS float* scr, int lane) {
    const int nblk = DFF / 64, kb = item / nblk, nb = item % nblk, n0 = nb * 64;
    transpose_item(W, DFF, DM, WT, gain, (n0 >> 7) * 256 + (n0 & 127) + up * 128, kb * 64, n0, scr, lane);
}
constexpr int PREP_NIT = 4 * ((DM / 64) * (DFF / 64)) + 2 * ((DFF / 64) * (DM / 64)) + (DM / 64) * (DIN / 64) + 3 * ((512 / 64) * (DM / 64)) + (DM / 64) * (DM / 64);
constexpr int PREP_EARLY = 3 * ((DM / 64) * (DFF / 64)) + (DM / 64) * (DIN / 64);
__device__ __forceinline__ void prep_weights(ArgP ap, int l, LAS unsigned char* lds, int tid, int gw, int NGW, int it_lo, int it_hi) {
    const int lane = tid & 63, wv = tid >> 6;
    LAS float* scr = (LAS float*)(lds + wv * 17408);
    unsigned char* wb = ap->ws + WS_W;
    constexpr int I_G = (DM / 64) * (DFF / 64), I_D = (DFF / 64) * (DM / 64), I_IN = (DM / 64) * (DIN / 64), I_B = (512 / 64) * (DM / 64), I_O = (DM / 64) * (DM / 64);
    static_assert(PREP_NIT == 4 * I_G + 2 * I_D + I_IN + 3 * I_B + I_O && PREP_EARLY == 2 * I_G + I_D + I_IN, "item counts");
    const size_t oGU = (size_t)l * DM * DFF, oD = (size_t)l * DFF * DM;
    for (int it = it_lo + gw; it < it_hi; it += NGW) {
        int r = it;
        if (r < I_G) { tr_gu(ap->in[2] + oGU, (bf16_t*)(wb + W_GU1), ap->in[1] + l * DM, 0, r, scr, lane); continue; } r -= I_G;
        if (r < I_G) { tr_gu(ap->in[3] + oGU, (bf16_t*)(wb + W_GU1), ap->in[1] + l * DM, 1, r, scr, lane); continue; } r -= I_G;
        if (r < I_D) { tr_plain(ap->in[4] + oD, DFF, DM, (bf16_t*)(wb + W_D1), nullptr, r, scr, lane); continue; } r -= I_D;
        if (r < I_IN) { tr_plain(ap->in[6] + (size_t)l * DM * DIN, DM, DIN, (bf16_t*)(wb + W_IN), ap->in[5] + l * DM, r, scr, lane); continue; } r -= I_IN;
        if (r < I_B) { tr_plain(ap->in[14] + (size_t)l * 512 * DM, 512, DM, (bf16_t*)(wb + W_BA), nullptr, r, scr, lane, 1536, 0); continue; } r -= I_B;
        if (r < I_B) { tr_plain(ap->in[15] + (size_t)l * 512 * DM, 512, DM, (bf16_t*)(wb + W_BA), nullptr, r, scr, lane, 1536, 512); continue; } r -= I_B;
        if (r < I_B) { tr_plain(ap->in[16] + (size_t)l * 512 * DM, 512, DM, (bf16_t*)(wb + W_BA), nullptr, r, scr, lane, 1536, 1024); continue; } r -= I_B;
        if (r < I_O) { tr_plain(ap->in[17] + (size_t)l * DM * DM, DM, DM, (bf16_t*)(wb + W_OUT), nullptr, r, scr, lane); continue; } r -= I_O;
        if (r < I_G) { tr_gu(ap->in[19] + oGU, (bf16_t*)(wb + W_GU2), ap->in[18] + l * DM, 0, r, scr, lane); continue; } r -= I_G;
        if (r < I_G) { tr_gu(ap->in[20] + oGU, (bf16_t*)(wb + W_GU2), ap->in[18] + l * DM, 1, r, scr, lane); continue; } r -= I_G;
        tr_plain(ap->in[21] + oD, DFF, DM, (bf16_t*)(wb + W_D2), nullptr, r, scr, lane);
    }
}

__device__ __forceinline__ void norm_rows(const float* src, bf16_t* xn, float* outf, const float* gain, unsigned* rs_out, int tid, int bid, int nbk) {
    const int lane = tid & 63, wv = tid >> 6;
    const int gw = bid * 8 + wv, NGW = nbk * 8;
    for (int m = gw; m < MTOK; m += NGW) {
        const float* xr = src + (size_t)m * DM + lane * 8;
        f32x4 v[4]; float s = 0.f;
#pragma unroll
        for (int j = 0; j < 4; ++j) { v[j] = *(const f32x4*)(xr + (j >> 1) * 512 + (j & 1) * 4); s += (v[j][0] * v[j][0] + v[j][1] * v[j][1]) + (v[j][2] * v[j][2] + v[j][3] * v[j][3]); }
        const float tot = wave_sum(s);
        if (rs_out && lane == 0) rs_out[m] = (unsigned)(tot * 1024.f + 0.5f);
        bf16_t* o = xn + (size_t)m * DM + lane * 8;
#pragma unroll
        for (int hh = 0; hh < 2; ++hh) { u32x4 w; w.x = pk2(v[2 * hh][0], v[2 * hh][1]); w.y = pk2(v[2 * hh][2], v[2 * hh][3]); w.z = pk2(v[2 * hh + 1][0], v[2 * hh + 1][1]); w.w = pk2(v[2 * hh + 1][2], v[2 * hh + 1][3]); *(u32x4*)(o + hh * 512) = w; }
    }
}
__device__ __forceinline__ void final_norm_rows(const bf16_t* xb, float* outf, const float* gain, int tid, int bid, int nbk) {
    const int lane = tid & 63, wv = tid >> 6;
    const int gw = bid * 8 + wv, NGW = nbk * 8;
    for (int m = gw; m < MTOK; m += NGW) {
        const bf16_t* xr = xb + (size_t)m * DM + lane * 8;
        const u32x4 a = *(const u32x4*)xr, b = *(const u32x4*)(xr + 512);
        float v[16];
        v[0] = bflo(a.x); v[1] = bfhi(a.x); v[2] = bflo(a.y); v[3] = bfhi(a.y); v[4] = bflo(a.z); v[5] = bfhi(a.z); v[6] = bflo(a.w); v[7] = bfhi(a.w);
        v[8] = bflo(b.x); v[9] = bfhi(b.x); v[10] = bflo(b.y); v[11] = bfhi(b.y); v[12] = bflo(b.z); v[13] = bfhi(b.z); v[14] = bflo(b.w); v[15] = bfhi(b.w);
        float s = 0.f;
#pragma unroll
        for (int i = 0; i < 16; ++i) s += v[i] * v[i];
        const float r = 1.0f / sqrtf(wave_sum(s) * (1.f / DM) + 1e-6f);
        float* o = outf + (size_t)m * DM + lane * 8; const float* g = gain + lane * 8;
#pragma unroll
        for (int hh = 0; hh < 2; ++hh)
#pragma unroll
            for (int q = 0; q < 2; ++q) { const f32x4 gg = *(const f32x4*)(g + hh * 512 + q * 4); f32x4 ov; ov[0] = v[hh * 8 + q * 4 + 0] * r * gg[0]; ov[1] = v[hh * 8 + q * 4 + 1] * r * gg[1]; ov[2] = v[hh * 8 + q * 4 + 2] * r * gg[2]; ov[3] = v[hh * 8 + q * 4 + 3] * r * gg[3]; *(f32x4*)(o + hh * 512 + q * 4) = ov; }
    }
}

template <int DVT, int NKB, bool MASKED, bool EDGE = true>
__device__ __forceinline__ void attn_step(const LAS unsigned char* kbase, int kstr, const LAS unsigned char* vbase, int vstr, bf16x8 q0, bf16x8 q1,
                                          f32x4 (&o)[DVT], float& m, float& l, float relq, float nslope, int kidx0, int klim, int tid) {
    const int lane = tid & 63, fr = lane & 15, quad = lane >> 4;
    f32x4 s[NKB][2];
    float mx = -1e30f;
#pragma unroll
    for (int nb = 0; nb < NKB; ++nb)
#pragma unroll
        for (int t = 0; t < 2; ++t) {
            const LAS unsigned char* kp = kbase + (nb * 32 + t * 16 + fr) * kstr + quad * 16;
            const bf16x8 k0 = *(const LAS bf16x8*)kp, k1 = *(const LAS bf16x8*)(kp + 64);
            const bool DEAD = MASKED && NKB == 5 && nb == 4 && t == 1;
            const bool BAND = MASKED && (NKB != 5 || (nb == 0 && t == 0) || nb == 4);
            f32x4 acc = {0.f, 0.f, 0.f, 0.f};
            if (DEAD) { acc = (f32x4){-1e30f, -1e30f, -1e30f, -1e30f}; }
            else {
#pragma unroll
                for (int j = 0; j < 4; ++j) acc[j] = nslope * __builtin_fabsf(relq - (float)(nb * 32 + t * 16 + j));
                acc = mfma16(k0, q0, acc); acc = mfma16(k1, q1, acc);
#pragma unroll
                for (int j = 0; j < 4; ++j) {
                    const float rel = relq - (float)(nb * 32 + t * 16 + j);
                    float v = acc[j];
                    if (MASKED) {
                        bool ok = true;
                        if (BAND) ok = (__builtin_fabsf(rel) <= 64.f);
                        if (EDGE) { const int kidx = kidx0 + nb * 32 + t * 16 + quad * 4 + j; ok = ok && (kidx >= 0) && (kidx < klim); }
                        if (BAND || EDGE) v = ok ? v : -1e30f;
                    }
                    acc[j] = v; mx = fmaxf(mx, v);
                }
            }
            s[nb][t] = acc;
        }
    mx = fmaxf(mx, __shfl_xor(mx, 16)); mx = fmaxf(mx, __shfl_xor(mx, 32));
    const float mn = fmaxf(m, mx), alpha = fexp2(m - mn);
    m = mn;
    float ps = 0.f;
#pragma unroll
    for (int nb = 0; nb < NKB; ++nb)
#pragma unroll
        for (int t = 0; t < 2; ++t)
#pragma unroll
            for (int j = 0; j < 4; ++j) { const float p = fexp2(s[nb][t][j] - mn); s[nb][t][j] = p; ps += p; }
    l = l * alpha + ps;
#pragma unroll
    for (int d = 0; d < DVT; ++d) o[d] = o[d] * alpha;
#pragma unroll
    for (int nb = 0; nb < NKB; ++nb) {
        const bf16x8 pf = pack8(s[nb][0], s[nb][1]);
        const LAS unsigned char* vp = vbase + (nb * 32 + quad * 4 + (fr >> 2)) * vstr + (fr & 3) * 8;
#pragma unroll
        for (int d = 0; d < DVT; ++d) {
            const bool dead1 = MASKED && NKB == 5 && nb == 4;
            const s16x4 v0 = ldtr(vp + d * 32), v1 = ldtr(vp + (dead1 ? 0 : 16 * vstr) + d * 32);
            o[d] = mfma16(cat8(v0, v1), pf, o[d]);
        }
    }
}

template <int DVT, int NKB>
__device__ __forceinline__ void attn_step2(const LAS unsigned char* kbase, int kstr, const LAS unsigned char* vbase, int vstr, bf16x8 qa0, bf16x8 qa1, bf16x8 qb0, bf16x8 qb1,
                                           f32x4 (&oa)[DVT], f32x4 (&ob)[DVT], float& ma, float& la, float& mb, float& lb, float relq, float nslope, int tid) {
    const int lane = tid & 63, fr = lane & 15, quad = lane >> 4;
    f32x4 sa[NKB][2], sb[NKB][2];
    float mxa = -1e30f, mxb = -1e30f;
#pragma unroll
    for (int nb = 0; nb < NKB; ++nb)
#pragma unroll
        for (int t = 0; t < 2; ++t) {
            const LAS unsigned char* kp = kbase + (nb * 32 + t * 16 + fr) * kstr + quad * 16;
            const bf16x8 k0 = *(const LAS bf16x8*)kp, k1 = *(const LAS bf16x8*)(kp + 64), k2 = *(const LAS bf16x8*)(kp + 128), k3 = *(const LAS bf16x8*)(kp + 192);
            f32x4 b4;
#pragma unroll
            for (int j = 0; j < 4; ++j) b4[j] = nslope * __builtin_fabsf(relq - (float)(nb * 32 + t * 16 + j));
            f32x4 aa = mfma16(k0, qa0, b4), ab = mfma16(k2, qb0, b4);
            aa = mfma16(k1, qa1, aa); ab = mfma16(k3, qb1, ab);
#pragma unroll
            for (int j = 0; j < 4; ++j) { mxa = fmaxf(mxa, aa[j]); mxb = fmaxf(mxb, ab[j]); }
            sa[nb][t] = aa; sb[nb][t] = ab;
        }
    if (!__any((mxa - ma > -140.f) || (mxb - mb > -140.f))) return;
    mxa = fmaxf(mxa, __shfl_xor(mxa, 16)); mxb = fmaxf(mxb, __shfl_xor(mxb, 16));
    mxa = fmaxf(mxa, __shfl_xor(mxa, 32)); mxb = fmaxf(mxb, __shfl_xor(mxb, 32));
    const float mna = fmaxf(ma, mxa), mnb = fmaxf(mb, mxb);
    if (__any((mna > ma) || (mnb > mb))) {
        const float ala = fexp2(ma - mna), alb = fexp2(mb - mnb);
        la *= ala; lb *= alb;
#pragma unroll
        for (int d = 0; d < DVT; ++d) { oa[d] = oa[d] * ala; ob[d] = ob[d] * alb; }
        ma = mna; mb = mnb;
    }
    float psa = 0.f, psb = 0.f;
#pragma unroll
    for (int nb = 0; nb < NKB; ++nb) {
#pragma unroll
        for (int t = 0; t < 2; ++t)
#pragma unroll
            for (int j = 0; j < 4; ++j) { const float pa = fexp2(sa[nb][t][j] - ma), pb = fexp2(sb[nb][t][j] - mb); sa[nb][t][j] = pa; sb[nb][t][j] = pb; psa += pa; psb += pb; }
        const bf16x8 pfa = pack8(sa[nb][0], sa[nb][1]), pfb = pack8(sb[nb][0], sb[nb][1]);
        const LAS unsigned char* vp = vbase + (nb * 32 + quad * 4 + (fr >> 2)) * vstr + (fr & 3) * 8;
        __builtin_amdgcn_s_setprio(1);
#pragma unroll
        for (int d = 0; d < DVT; ++d) {
            const bf16x8 vf = cat8(ldtr(vp + d * 32), ldtr(vp + 16 * vstr + d * 32));
            oa[d] = mfma16(vf, pfa, oa[d]); ob[d] = mfma16(vf, pfb, ob[d]);
        }
        __builtin_amdgcn_s_setprio(0);
    }
    la += psa; lb += psb;
}
constexpr int DA_KSTR = 272, DA_VSTR = 288, DA_KB = 64 * DA_KSTR, DA_BUF = DA_KB + 64 * DA_VSTR;
__device__ __forceinline__ int da_order(int i, int qt) {
    const int c = 2 * qt;
    if (i < 2) return c + i;
    const int j = i - 2, L = c, R = 30 - c, mn = L < R ? L : R;
    if (j < 2 * mn) return (j & 1) ? (c + 2 + (j >> 1)) : (c - 1 - (j >> 1));
    const int rem = j - 2 * mn;
    return (L > R) ? (c - 1 - mn - rem) : (c + 2 + mn + rem);
}
__device__ __forceinline__ void diff_unit(LAS unsigned char* lds, const bf16_t* zA, bf16_t* ya, int bl, int h, int qt, float slope, float lam, float oml, const float* subln, int tid) {
    const int lane = tid & 63, wv = __builtin_amdgcn_readfirstlane(tid >> 6), fr = lane & 15, quad = lane >> 4;
    const size_t rb = (size_t)bl * SEQ;
    const int qpos = qt * 128 + wv * 16 + fr;
    const bf16_t* qp = zA + (rb + qpos) * 1536 + h * 128 + quad * 8;
    const bf16x8 qa0 = *(const bf16x8*)qp, qa1 = *(const bf16x8*)(qp + 32), qb0 = *(const bf16x8*)(qp + 64), qb1 = *(const bf16x8*)(qp + 96);
    f32x4 oa[8], ob[8];
#pragma unroll
    for (int d = 0; d < 8; ++d) { oa[d] = (f32x4){0.f, 0.f, 0.f, 0.f}; ob[d] = (f32x4){0.f, 0.f, 0.f, 0.f}; }
    float ma = -1e30f, la = 0.f, mb = -1e30f, lb = 0.f;
    const float nslope = -slope * LOG2E;
    const int r0 = tid >> 4, ch = tid & 15;
    const bf16_t* kg = zA + (rb + r0) * 1536 + 512 + h * 128 + ch * 8;
    const bf16_t* vg = zA + (rb + r0) * 1536 + 1024 + h * 128 + ch * 8;
    u32x4 pk_[2], pv_[2];
    int ktile = da_order(0, qt);
#pragma unroll
    for (int j = 0; j < 2; ++j) { pk_[j] = *(const u32x4*)(kg + (size_t)(ktile * 64 + j * 32) * 1536); pv_[j] = *(const u32x4*)(vg + (size_t)(ktile * 64 + j * 32) * 1536); }
#pragma unroll
    for (int j = 0; j < 2; ++j) { *(LAS u32x4*)(lds + (r0 + j * 32) * DA_KSTR + ch * 16) = pk_[j]; *(LAS u32x4*)(lds + DA_KB + (r0 + j * 32) * DA_VSTR + ch * 16) = pv_[j]; }
    __syncthreads();
    for (int kt = 0; kt < 32; ++kt) {
        const int cb = (kt & 1) * DA_BUF, nb_ = ((kt + 1) & 1) * DA_BUF;
        const int knext = da_order(kt + 1 < 32 ? kt + 1 : 31, qt);
        if (kt + 1 < 32) {
#pragma unroll
            for (int j = 0; j < 2; ++j) { pk_[j] = *(const u32x4*)(kg + (size_t)(knext * 64 + j * 32) * 1536); pv_[j] = *(const u32x4*)(vg + (size_t)(knext * 64 + j * 32) * 1536); }
        }
        const float relq = (float)(qpos - ktile * 64 - quad * 4);
        attn_step2<8, 2>(lds + cb, DA_KSTR, lds + cb + DA_KB, DA_VSTR, qa0, qa1, qb0, qb1, oa, ob, ma, la, mb, lb, relq, nslope, tid);
        if (kt + 1 < 32) {
#pragma unroll
            for (int j = 0; j < 2; ++j) { *(LAS u32x4*)(lds + nb_ + (r0 + j * 32) * DA_KSTR + ch * 16) = pk_[j]; *(LAS u32x4*)(lds + nb_ + DA_KB + (r0 + j * 32) * DA_VSTR + ch * 16) = pv_[j]; }
        }
        ktile = knext;
        __syncthreads();
    }
    la += __shfl_xor(la, 16); la += __shfl_xor(la, 32); lb += __shfl_xor(lb, 16); lb += __shfl_xor(lb, 32);
    const float ila = frcp(la), ilb = lam * frcp(lb);
    float ss = 0.f;
#pragma unroll
    for (int d = 0; d < 8; ++d) { oa[d] = oa[d] * ila - ob[d] * ilb; ss += (oa[d][0] * oa[d][0] + oa[d][1] * oa[d][1]) + (oa[d][2] * oa[d][2] + oa[d][3] * oa[d][3]); }
    ss += __shfl_xor(ss, 16); ss += __shfl_xor(ss, 32);
    const float rn = oml / sqrtf(ss * (1.f / 128.f) + 1e-6f);
    bf16_t* yp = ya + (rb + qpos) * 1536 + h * 128 + quad * 4;
#pragma unroll
    for (int d = 0; d < 8; ++d) { const f32x4 g = *(const f32x4*)(subln + d * 16 + quad * 4); u32x2 w; w.x = pk2(oa[d][0] * rn * g[0], oa[d][1] * rn * g[1]); w.y = pk2(oa[d][2] * rn * g[2], oa[d][3] * rn * g[3]); *(u32x2*)(yp + d * 16) = w; }
}

constexpr int DL_STR = 144, DL_KB = 256 * DL_STR;
__device__ __forceinline__ void dil_unit(LAS unsigned char* lds, const bf16_t* zB, bf16_t* OP, float* LSE, int bl, int h, int pi, int su, float slope, int tid) {
    const int lane = tid & 63, wv = __builtin_amdgcn_readfirstlane(tid >> 6), fr = lane & 15, quad = lane >> 4;
    const int d = (pi == 0) ? 1 : ((pi == 1) ? 4 : 16), L = SEQ / d, nseg = L / 128;
    const size_t rb = (size_t)bl * SEQ;
    u32x4 kv_[4], vv_[4]; bf16x8 qn0, qn1;
#define DL_LOAD(S16) do { const int r_ = (S16) / nseg, m0_ = ((S16) % nseg) * 128; \
        _Pragma("unroll") for (int j = 0; j < 4; ++j) { const int id = tid + j * 512, row = id >> 3, ch = id & 7; int mk = m0_ - 64 + row; mk = mk < 0 ? 0 : (mk > L - 1 ? L - 1 : mk); \
            const bf16_t* src = zB + (rb + (size_t)(mk * d + r_)) * 1536 + h * 64 + ch * 8; kv_[j] = *(const u32x4*)(src + 512); vv_[j] = *(const u32x4*)(src + 1024); } \
        const bf16_t* qp_ = zB + (rb + (size_t)((m0_ + wv * 16 + fr) * d + r_)) * 1536 + h * 64 + quad * 8; qn0 = *(const bf16x8*)qp_; qn1 = *(const bf16x8*)(qp_ + 32); } while (0)
#define DL_STORE() do { _Pragma("unroll") for (int j = 0; j < 4; ++j) { const int id = tid + j * 512, row = id >> 3, ch = id & 7; \
            *(LAS u32x4*)(lds + row * DL_STR + ch * 16) = kv_[j]; *(LAS u32x4*)(lds + DL_KB + row * DL_STR + ch * 16) = vv_[j]; } } while (0)
    DL_LOAD(4 * su);
    DL_STORE();
    __syncthreads();
#pragma unroll 1
    for (int i = 0; i < 4; ++i) {
        const int s16 = 4 * su + i, r = s16 / nseg, m0 = (s16 % nseg) * 128;
        const bf16x8 q0 = qn0, q1 = qn1;
        if (i < 3) DL_LOAD(s16 + 1);
        f32x4 o[4];
#pragma unroll
        for (int t = 0; t < 4; ++t) o[t] = (f32x4){0.f, 0.f, 0.f, 0.f};
        float m = -1e30f, l = 0.f;
        const float relq = (float)(fr + 64 - quad * 4);
        const int kidx0 = m0 - 64 + wv * 16;
        if (kidx0 < 0 || kidx0 + 160 > L)
            attn_step<4, 5, true, true>(lds + (wv * 16) * DL_STR, DL_STR, lds + DL_KB + (wv * 16) * DL_STR, DL_STR, q0, q1, o, m, l, relq, -slope * LOG2E * (float)d, kidx0, L, tid);
        else
            attn_step<4, 5, true, false>(lds + (wv * 16) * DL_STR, DL_STR, lds + DL_KB + (wv * 16) * DL_STR, DL_STR, q0, q1, o, m, l, relq, -slope * LOG2E * (float)d, kidx0, L, tid);
        l += __shfl_xor(l, 16); l += __shfl_xor(l, 32);
        const float il = frcp(l);
        const size_t qrow = rb + (size_t)((m0 + wv * 16 + fr) * d + r);
        bf16_t* op = OP + ((size_t)pi * MH + qrow) * 512 + h * 64 + quad * 4;
#pragma unroll
        for (int t = 0; t < 4; ++t) { u32x2 w; w.x = pk2(o[t][0] * il, o[t][1] * il); w.y = pk2(o[t][2] * il, o[t][3] * il); *(u32x2*)(op + t * 16) = w; }
        if (quad == 0) LSE[((size_t)pi * MH + qrow) * 8 + h] = m + flog2(l);
        if (i < 3) { __syncthreads(); DL_STORE(); __syncthreads(); }
    }
#undef DL_LOAD
#undef DL_STORE
}

constexpr int HG_QE = 0, HG_KN = 17408, HG_KET = 34816, HG_VV = 53248, HG_STB = 71680, HG_EBT = 106496, HG_SUB = 107008;
__device__ __forceinline__ int hg_row(int bl, int dir, int c, int t) { const int s = c * 64 + t; return bl * SEQ + (dir ? (SEQ - 1 - s) : s); }
__device__ __forceinline__ void hgrn_unit(LAS unsigned char* lds, bf16_t* zC, int bl, int h, int dir, float lb, int tid, bf16_t* ob, int ostr, int ocol) {
    const int lane = tid & 63, wv = __builtin_amdgcn_readfirstlane(tid >> 6), fr = lane & 15, quad = lane >> 4;
    const int k = tid & 127, tq = tid >> 7;
    const float oml = 1.f - lb;
    const int fcol = 512 + dir * 512 + h * 128;
    f32x4 st[8];
#pragma unroll
    for (int i = 0; i < 8; ++i) st[i] = (f32x4){0.f, 0.f, 0.f, 0.f};
    u32x4 vp_[2], qp_[2], fp_[2];
#define HG_PREFETCH(C) do { _Pragma("unroll") for (int j = 0; j < 2; ++j) { const int id = tid + j * 512; const bf16_t* rp_ = zC + (size_t)hg_row(bl, dir, (C), id >> 4) * 2560 + h * 128 + (id & 15) * 8; \
        qp_[j] = *(const u32x4*)rp_; fp_[j] = *(const u32x4*)(rp_ + fcol - h * 128); vp_[j] = *(const u32x4*)(rp_ + 1536); } } while (0)
    HG_PREFETCH(0);
    for (int c = 0; c < 32; ++c) {
#pragma unroll
        for (int j = 0; j < 2; ++j) { const int id = tid + j * 512; *(LAS u32x4*)(lds + HG_QE + (id >> 4) * 272 + (id & 15) * 16) = qp_[j]; *(LAS u32x4*)(lds + HG_KN + (id >> 4) * 272 + (id & 15) * 16) = fp_[j];
            *(LAS u32x4*)(lds + HG_VV + (id >> 4) * 288 + (id & 15) * 16) = vp_[j]; }
        __syncthreads();
        float bl_[16], kk_[16]; float run = 0.f;
        {
            float t_[16];
#pragma unroll
            for (int i = 0; i < 16; ++i) t_[i] = -LOG2E * bf2f(*(const LAS unsigned short*)(lds + HG_KN + (tq * 16 + i) * 272 + k * 2));
            __builtin_amdgcn_sched_barrier(0);
#pragma unroll
            for (int i = 0; i < 16; ++i) t_[i] = fexp2(t_[i]);
            __builtin_amdgcn_sched_barrier(0);
#pragma unroll
            for (int i = 0; i < 16; ++i) t_[i] = frcp(1.f + t_[i]);
            __builtin_amdgcn_sched_barrier(0);
#pragma unroll
            for (int i = 0; i < 16; ++i) { kk_[i] = oml * (1.f - t_[i]); t_[i] = flog2(lb + oml * t_[i]); }
            __builtin_amdgcn_sched_barrier(0);
#pragma unroll
            for (int i = 0; i < 16; ++i) { run += fmaxf(t_[i], -100.f); bl_[i] = run; }
        }
        ((LAS float*)(lds + HG_SUB))[tq * 128 + k] = run;
#pragma unroll
        for (int kt = 0; kt < 8; ++kt)
#pragma unroll
            for (int j = 0; j < 4; ++j) *(LAS unsigned short*)(lds + HG_STB + (wv * 16 + quad * 4 + j) * 272 + (kt * 16 + fr) * 2) = f2bf(st[kt][j]);
        __syncthreads();
        {
            const LAS float* SUB = (const LAS float*)(lds + HG_SUB);
            const float s0 = SUB[k], s1 = SUB[128 + k], s2 = SUB[256 + k], s3 = SUB[384 + k];
            const float bn = (tq > 0 ? s0 : 0.f) + (tq > 1 ? s1 : 0.f) + (tq > 2 ? s2 : 0.f);
            const float btot = (s0 + s1) + (s2 + s3);
            float ke_[16];
#pragma unroll
            for (int i = 0; i < 16; ++i) {
                const float bc = bn + bl_[i];
                const float q = bf2f(*(const LAS unsigned short*)(lds + HG_QE + (tq * 16 + i) * 272 + k * 2));
                const float qe = q * fexp2(bc);
                const float kn = kk_[i] * fexp2(fminf(-bc, 110.f));
                ke_[i] = kk_[i] * fexp2(btot - bc);
                *(LAS unsigned short*)(lds + HG_QE + (tq * 16 + i) * 272 + k * 2) = f2bf(qe);
                *(LAS unsigned short*)(lds + HG_KN + (tq * 16 + i) * 272 + k * 2) = f2bf(kn);
            }
            u32x4 w0, w1;
            w0.x = pk2(ke_[0], ke_[1]); w0.y = pk2(ke_[2], ke_[3]); w0.z = pk2(ke_[4], ke_[5]); w0.w = pk2(ke_[6], ke_[7]);
            w1.x = pk2(ke_[8], ke_[9]); w1.y = pk2(ke_[10], ke_[11]); w1.z = pk2(ke_[12], ke_[13]); w1.w = pk2(ke_[14], ke_[15]);
            *(LAS u32x4*)(lds + HG_KET + k * 144 + tq * 32) = w0; *(LAS u32x4*)(lds + HG_KET + k * 144 + tq * 32 + 16) = w1;
            if (tq == 0) ((LAS float*)(lds + HG_EBT))[k] = fexp2(btot);
        }
        __syncthreads();
        if (c + 1 < 32) HG_PREFETCH(c + 1);
        f32x4 o[4];
#pragma unroll
        for (int tt = 0; tt < 4; ++tt) o[tt] = (f32x4){0.f, 0.f, 0.f, 0.f};
#pragma unroll
        for (int sb = 0; sb < 2; ++sb) {
            f32x4 at[2][4];
#pragma unroll
            for (int ts = 0; ts < 2; ++ts)
#pragma unroll
                for (int tt = 0; tt < 4; ++tt) at[ts][tt] = (f32x4){0.f, 0.f, 0.f, 0.f};
#pragma unroll
            for (int ks = 0; ks < 4; ++ks) {
                bf16x8 qf[4];
#pragma unroll
                for (int tt = 0; tt < 4; ++tt) if (tt >= 2 * sb) qf[tt] = *(const LAS bf16x8*)(lds + HG_QE + (tt * 16 + fr) * 272 + (ks * 32 + quad * 8) * 2);
                if (sb == 0) {
                    const bf16x8 sa = *(const LAS bf16x8*)(lds + HG_STB + (wv * 16 + fr) * 272 + (ks * 32 + quad * 8) * 2);
#pragma unroll
                    for (int tt = 0; tt < 4; ++tt) o[tt] = mfma16(sa, qf[tt], o[tt]);
                }
#pragma unroll
                for (int ts = 0; ts < 2; ++ts) {
                    const int a = sb * 2 + ts;
                    const bf16x8 kf = *(const LAS bf16x8*)(lds + HG_KN + (a * 16 + fr) * 272 + (ks * 32 + quad * 8) * 2);
#pragma unroll
                    for (int tt = 0; tt < 4; ++tt) if (tt >= a) at[ts][tt] = mfma16(kf, qf[tt], at[ts][tt]);
                }
            }
#pragma unroll
            for (int ts = 0; ts < 2; ++ts)
#pragma unroll
                for (int j = 0; j < 4; ++j) at[ts][sb * 2 + ts][j] = (quad * 4 + j > fr) ? 0.f : at[ts][sb * 2 + ts][j];
            const LAS unsigned char* vp = lds + HG_VV + (sb * 32 + quad * 4 + (fr >> 2)) * 288 + (wv * 16 + (fr & 3) * 4) * 2;
            const bf16x8 vf = cat8(ldtr(vp), ldtr(vp + 16 * 288));
#pragma unroll
            for (int tt = 0; tt < 4; ++tt) if (tt >= 2 * sb) o[tt] = mfma16(vf, pack8(at[0][tt], at[1][tt]), o[tt]);
        }
#pragma unroll
        for (int kt = 0; kt < 8; ++kt) { const float eb = ((const LAS float*)(lds + HG_EBT))[kt * 16 + fr]; st[kt] = st[kt] * eb; }
#pragma unroll
        for (int tb = 0; tb < 2; ++tb) {
            const LAS unsigned char* vp = lds + HG_VV + (tb * 32 + quad * 8 + (fr >> 2)) * 288 + (wv * 16 + (fr & 3) * 4) * 2;
            const bf16x8 vf = cat8(ldtr(vp), ldtr(vp + 4 * 288));
#pragma unroll
            for (int kt = 0; kt < 8; ++kt) { const bf16x8 kb = *(const LAS bf16x8*)(lds + HG_KET + (kt * 16 + fr) * 144 + (tb * 32 + quad * 8) * 2); st[kt] = mfma16(vf, kb, st[kt]); }
        }
#pragma unroll
        for (int tt = 0; tt < 4; ++tt) { u32x2 w; w.x = pk2(o[tt][0], o[tt][1]); w.y = pk2(o[tt][2], o[tt][3]);
            *(u32x2*)(ob + (size_t)hg_row(bl, dir, c, tt * 16 + fr) * ostr + ocol + wv * 16 + quad * 4) = w; }
        __syncthreads();
    }
#undef HG_PREFETCH
}

__device__ __forceinline__ void post_rows(const bf16_t* OP, const float* LSE, const bf16_t* zC, bf16_t* yb, bf16_t* yc, const float* hnorm, int tid, int bid, int nbk) {
    const int lane = tid & 63, wv = tid >> 6;
    const int gw = bid * 8 + wv, NGW = nbk * 8;
    for (int r = gw; r < MH; r += NGW) {
        {
            const int hb = lane >> 3;
            const float l0 = LSE[((size_t)0 * MH + r) * 8 + hb], l1 = LSE[((size_t)1 * MH + r) * 8 + hb], l2 = LSE[((size_t)2 * MH + r) * 8 + hb];
            const float mx = fmaxf(l0, fmaxf(l1, l2));
            float w0 = fexp2(l0 - mx), w1 = fexp2(l1 - mx), w2 = fexp2(l2 - mx);
            const float iw = frcp(w0 + w1 + w2); w0 *= iw; w1 *= iw; w2 *= iw;
            const u32x4 a = *(const u32x4*)(OP + ((size_t)0 * MH + r) * 512 + lane * 8), b = *(const u32x4*)(OP + ((size_t)1 * MH + r) * 512 + lane * 8), c = *(const u32x4*)(OP + ((size_t)2 * MH + r) * 512 + lane * 8);
            u32x4 o;
            o.x = pk2(w0 * bflo(a.x) + w1 * bflo(b.x) + w2 * bflo(c.x), w0 * bfhi(a.x) + w1 * bfhi(b.x) + w2 * bfhi(c.x));
            o.y = pk2(w0 * bflo(a.y) + w1 * bflo(b.y) + w2 * bflo(c.y), w0 * bfhi(a.y) + w1 * bfhi(b.y) + w2 * bfhi(c.y));
            o.z = pk2(w0 * bflo(a.z) + w1 * bflo(b.z) + w2 * bflo(c.z), w0 * bfhi(a.z) + w1 * bfhi(b.z) + w2 * bfhi(c.z));
            o.w = pk2(w0 * bflo(a.w) + w1 * bflo(b.w) + w2 * bflo(c.w), w0 * bfhi(a.w) + w1 * bfhi(b.w) + w2 * bfhi(c.w));
            *(u32x4*)(yb + (size_t)r * 1536 + lane * 8) = o;
        }
        {
            const bf16_t* zr = zC + (size_t)r * 2560 + lane * 8;
            const u32x4 a = *(const u32x4*)(zr + 512), b = *(const u32x4*)(zr + 1024), g = *(const u32x4*)(zr + 2048);
            float s[8], og[8];
            s[0] = bflo(a.x) + bflo(b.x); s[1] = bfhi(a.x) + bfhi(b.x); s[2] = bflo(a.y) + bflo(b.y); s[3] = bfhi(a.y) + bfhi(b.y);
            s[4] = bflo(a.z) + bflo(b.z); s[5] = bfhi(a.z) + bfhi(b.z); s[6] = bflo(a.w) + bflo(b.w); s[7] = bfhi(a.w) + bfhi(b.w);
            og[0] = bflo(g.x); og[1] = bfhi(g.x); og[2] = bflo(g.y); og[3] = bfhi(g.y); og[4] = bflo(g.z); og[5] = bfhi(g.z); og[6] = bflo(g.w); og[7] = bfhi(g.w);
            float ss = 0.f;
#pragma unroll
            for (int i = 0; i < 8; ++i) ss += s[i] * s[i];
            ss += __shfl_xor(ss, 1); ss += __shfl_xor(ss, 2); ss += __shfl_xor(ss, 4); ss += __shfl_xor(ss, 8);
            const float rn = 1.0f / sqrtf(ss * (1.f / 128.f) + 1e-6f);
            const float* gn = hnorm + (lane & 15) * 8;
            float y[8];
#pragma unroll
            for (int i = 0; i < 8; ++i) y[i] = s[i] * rn * gn[i] * siluf_(og[i]);
            u32x4 o; o.x = pk2(y[0], y[1]); o.y = pk2(y[2], y[3]); o.z = pk2(y[4], y[5]); o.w = pk2(y[6], y[7]);
            *(u32x4*)(yc + (size_t)r * 1536 + lane * 8) = o;
        }
    }
}

#define XB_TMO      128
#define XB_XCNT(j)  (256  + 64 * (j))
#define XB_XSUB(j)  (1280 + 64 * (j))
#define XB_XGEN(j)  (2304 + 64 * (j))
#define XB_TOP      3328
#define XB_TOPGEN   3392
#define XCD_BAR_WORDS 3456
#define XB_SPIN_CAP (1u << 18)

__device__ __forceinline__ unsigned xb_ld(unsigned* p)              { return __hip_atomic_load(p, __ATOMIC_RELAXED, __HIP_MEMORY_SCOPE_AGENT); }
__device__ __forceinline__ unsigned xb_add(unsigned* p, unsigned v) { return __hip_atomic_fetch_add(p, v, __ATOMIC_RELAXED, __HIP_MEMORY_SCOPE_AGENT); }
__device__ __forceinline__ unsigned xb_xcc_id() { return (unsigned)__builtin_amdgcn_s_getreg((3 << 11) | 20) & 0xFu; }
#define XB_SPIN(cond, bar) do { unsigned _sp = 0; while (cond) { __builtin_amdgcn_s_sleep(1); \
    if ((++_sp & 255u) == 0u) { if (xb_ld(&(bar)[XB_TMO])) break; if (_sp > XB_SPIN_CAP) { atomicAdd(&(bar)[XB_TMO], 1u); break; } } } } while (0)

struct XcdBarrier {
    unsigned* bar; unsigned x;
    volatile LAS unsigned* st;
};

__device__ __forceinline__ XcdBarrier xcd_barrier_post(unsigned* bar, volatile LAS unsigned* st) {
    XcdBarrier b; b.bar = bar; b.x = xb_xcc_id(); b.st = st;
    if (threadIdx.x == 0) (void)xb_add(&bar[XB_XCNT(b.x)], 1u);
    return b;
}
__device__ __forceinline__ void xcd_barrier_complete(unsigned* bar, unsigned x, unsigned& nloc, unsigned& nx) {
    const unsigned G = gridDim.x * gridDim.y * gridDim.z;
    unsigned sum, cnt, mine, sp = 0u;
    for (;;) {
        sum = 0u; cnt = 0u; mine = 0u;
#pragma unroll
        for (unsigned j = 0; j < 16; ++j) { const unsigned c = xb_ld(&bar[XB_XCNT(j)]); sum += c; cnt += (c > 0u) ? 1u : 0u; mine = (j == x) ? c : mine; }
        if (sum == G) break;
        __builtin_amdgcn_s_sleep(1);
        if ((++sp & 255u) == 0u) { if (xb_ld(&bar[XB_TMO])) break; if (sp > XB_SPIN_CAP) { atomicAdd(&bar[XB_TMO], 1u); break; } }
    }
    nloc = mine > 0u ? mine : 1u; nx = cnt > 0u ? cnt : 1u;
}

__device__ __forceinline__ void xcd_barrier(const XcdBarrier& b) {
    asm volatile("s_waitcnt vmcnt(0)" ::: "memory");
    __syncthreads();
    if (threadIdx.x == 0) {
        unsigned* bar = b.bar;
        __builtin_amdgcn_s_waitcnt(0);
        unsigned nloc = b.st[0], nx = b.st[1];
        if (nloc == 0u) { xcd_barrier_complete(bar, b.x, nloc, nx); b.st[0] = nloc; b.st[1] = nx; }
        const unsigned old = xb_add(&bar[XB_XSUB(b.x)], 1u);
        const unsigned gen = old / nloc;
        if (old + 1u == (gen + 1u) * nloc) {
            __builtin_amdgcn_fence(__ATOMIC_RELEASE, "agent");
            asm volatile("s_waitcnt vmcnt(0)" ::: "memory");
            const unsigned og = xb_add(&bar[XB_TOP], 1u);
            const unsigned tg = og / nx;
            if (og + 1u == (tg + 1u) * nx) xb_add(&bar[XB_TOPGEN], 1u);
            else XB_SPIN(xb_ld(&bar[XB_TOPGEN]) == tg, bar);
            __builtin_amdgcn_fence(__ATOMIC_ACQUIRE, "agent");
            xb_add(&bar[XB_XGEN(b.x)], 1u);
            asm volatile("s_waitcnt vmcnt(0)" ::: "memory");
        } else {
            XB_SPIN(xb_ld(&bar[XB_XGEN(b.x)]) == gen, bar);
            __builtin_amdgcn_fence(__ATOMIC_ACQUIRE, "agent");
            asm volatile("s_waitcnt vmcnt(0)" ::: "memory");
        }
    }
    __syncthreads();
}

template <class Epi>
__device__ __forceinline__ void run_gemm(LAS unsigned char* lds, const bf16_t* A, const bf16_t* Bt, int M, int N, int K, const Epi& E, int bid, int nbk) {
    pg8::Gemm g{A, Bt, M, N, K}; pg8::StaticOrder S; S.init(M, N, nbk, bid);
    pg8::gemm_phase<Epi, pg8::StaticOrder, true, true>(lds, g, S, E);
}

__global__ void __launch_bounds__(512, 2) mega_fwd(Args a) {
    extern __shared__ __attribute__((aligned(16))) unsigned char lds_raw[];
    LAS unsigned char* lds = (LAS unsigned char*)lds_raw;
    cg::grid_group grid = cg::this_grid();
    if (threadIdx.x < 4) ((LAS unsigned*)(lds + LDS_CTRL + 64))[threadIdx.x] = 0u;
    __syncthreads();
    const XcdBarrier xbar = xcd_barrier_post((unsigned*)(a.ws + WS_CTL) + CW_BAR, (volatile LAS unsigned*)(lds + LDS_CTRL + 64));
    const int ph_lo = a.ph_lo, ph_hi = a.ph_hi;
#pragma unroll 1
    for (int ph = ph_lo; ph < ph_hi; ++ph) {
    ArgP ap = (ArgP)__builtin_amdgcn_kernarg_segment_ptr(); asm volatile("" : "+s"(ap));
    int tid = threadIdx.x; asm volatile("" : "+v"(tid));
    int bid = blockIdx.x; asm volatile("" : "+s"(bid));
    int nbk = gridDim.x; asm volatile("" : "+s"(nbk));
    unsigned char* ws = ap->ws;
    unsigned char* wb = ws + WS_W;
    bf16_t* xn = (bf16_t*)(ws + WS_XN);
    bf16_t* act = (bf16_t*)(ws + WS_BIG);
    bf16_t *zA = (bf16_t*)(ws + WS_ZA), *zB = (bf16_t*)(ws + WS_ZB), *zC = (bf16_t*)(ws + WS_ZC), *zG = (bf16_t*)(ws + WS_ZG);
    float* mF = (float*)(ws + WS_MF); bf16_t* mB = (bf16_t*)(ws + WS_MB);
    bf16_t *ya = (bf16_t*)(ws + WS_YA), *yb = ya + 512, *yc = ya + 1024, *OP = (bf16_t*)(ws + WS_OP);
    float* LSE = (float*)(ws + WS_LSE);
    unsigned* RS = (unsigned*)(ws + WS_RS);
    const float* x = ap->in[0]; float* out = ap->out;

        if (ph == NPH - 1) {
            final_norm_rows(xn, out, ap->in[22], tid, bid, nbk);
        } else {
            const int l = ph / 17, r = ph % 17;
            if (r == 0) {
                prep_weights(ap, l, lds, tid, bid * 8 + (tid >> 6), nbk * 8, 0, PREP_EARLY);
                if (l == 0) norm_rows(x, xn, nullptr, nullptr, RS, tid, bid, nbk);
            } else if (r == 1 || r == 15) {
                pg8::EpiGU E{act, DFF, RS + (size_t)(l * 3 + (r == 1 ? 0 : 2)) * MTOK};
                run_gemm(lds, xn, (const bf16_t*)(wb + (r == 1 ? W_GU1 : W_GU2)), MTOK, 2 * DFF, DM, E, bid, nbk);
            } else if (r == 2 || r == 16) {
                pg8::EpiRes E{nullptr, xn, RS + (size_t)(r == 2 ? l * 3 + 1 : (l + 1) * 3) * MTOK, 1};
                run_gemm(lds, act, (const bf16_t*)(wb + (r == 2 ? W_D1 : W_D2)), MTOK, DM, DFF, E, bid, nbk);
            } else if (r == 3 || r == 14) {
                continue;
            } else {
                const int hs = (r - 4) / 5, kk = (r - 4) % 5;
                const size_t hrow0 = (size_t)hs * MH;
                if (kk == 0) {
                    pg8::EpiIn E{zA, zB, zC, zG, RS + (size_t)(l * 3 + 1) * MTOK + hrow0};
                    run_gemm(lds, xn + hrow0 * DM, (const bf16_t*)(wb + W_IN), MH, DIN, DM, E, bid, nbk);
                    if (hs == 0) {
                        const int nwg = (MH / 256) * (DIN / 256), first = nwg % nbk, nidle = nbk - first;
                        if (bid >= first) prep_weights(ap, l, lds, tid, (bid - first) * 8 + (tid >> 6), nidle * 8, PREP_EARLY, PREP_NIT);
                    }
                } else if (kk == 1) {
                    unsigned* counter = (unsigned*)(ws + WS_CTL) + 64 * (l * 2 + hs);
                    LAS int* shu = (LAS int*)(lds + LDS_CTRL);
                    const float lam_init = 0.8f - 0.6f * expf(-0.3f * (float)l);
                    float lam;
                    {
                        const int lane = tid & 63;
                        const float p1 = ap->in[7][l * 64 + lane] * ap->in[8][l * 64 + lane], p2 = ap->in[9][l * 64 + lane] * ap->in[10][l * 64 + lane];
                        lam = expf(wave_sum(p1)) - expf(wave_sum(p2)) + lam_init;
                    }
                    for (;;) {
                        __syncthreads();
                        if (tid == 0) *shu = (int)atomicAdd(counter, 1u);
                        __syncthreads();
                        const int u = *shu;
                        if (u >= NU_ALL + PROBE_DUP_H * NU_H + PROBE_DUP_A * (NU_D + NU_L)) break;
                        int tidu = tid; asm volatile("" : "+v"(tidu));
                        int u2 = u;
#if PROBE_DUP_H
                        const bool dummy = u2 < NU_H; if (!dummy) u2 -= NU_H;
#else
                        const bool dummy = false;
#endif
#if PROBE_DUP_A
                        if (u2 >= NU_ALL) u2 -= (NU_D + NU_L);
#endif
                        if (dummy || u2 < NU_H) {
                            const int dir = u2 & 1, h = (u2 >> 1) & 3, bl = u2 >> 3;
                            float lb = 0.f;
                            if (l == 1) { const int k = tidu & 127; const float x0 = ap->in[12][h * 128 + k], x1 = ap->in[12][512 + h * 128 + k]; const float mx = fmaxf(x0, x1); const float e0 = expf(x0 - mx), e1 = expf(x1 - mx); lb = e1 / (e0 + e1); }
                            if (dummy) hgrn_unit(lds, zC, bl, h, dir, lb, tidu, OP, 1024, dir * 512 + h * 128);
                            else hgrn_unit(lds, zC, bl, h, dir, lb, tidu, zC, 2560, 512 + dir * 512 + h * 128);
                        } else if (u2 < NU_H + NU_D) {
                            const int v = u2 - NU_H, qt = v & 15, h = (v >> 4) & 3, bl = v >> 6;
                            const float slope = exp2f(-8.0f * (float)(3 * h + 1) / 12.0f);
                            diff_unit(lds, zA, ya, bl, h, qt, slope, lam, 1.f - lam_init, ap->in[11] + l * 128, tidu);
                        } else {
                            const int v = u2 - NU_H - NU_D, s16 = v & 3, t = v >> 2, pi = t % 3, t2 = t / 3, h = t2 & 7, bl = t2 >> 3;
                            const int aidx = h + 1 + (h >> 1);
                            const float slope = exp2f(-8.0f * (float)(aidx + 1) / 12.0f);
                            dil_unit(lds, zB, OP, LSE, bl, h, pi, s16, slope, tidu);
                        }
                    }
                } else if (kk == 2) {
                    post_rows(OP, LSE, zC, yb, yc, ap->in[13] + l * 128, tid, bid, nbk);
                } else if (kk == 3) {
                    pg8::EpiBr E{zG, mB};
                    run_gemm(lds, ya, (const bf16_t*)(wb + W_BA), MH, DM, 1536, E, bid, nbk);
                } else {
                    pg8::EpiRes E{nullptr, xn + hrow0 * DM, RS + (size_t)(l * 3 + 2) * MTOK + hrow0, 0};
                    run_gemm(lds, mB, (const bf16_t*)(wb + W_OUT), MH, DM, DM, E, bid, nbk);
                }
            }
        }
        if (ph + 1 < ph_hi) { if (ph == ph_lo) grid.sync(); else xcd_barrier(xbar); }
    }
}

#ifndef N_LAUNCH_SPLIT
#define N_LAUNCH_SPLIT 0
#endif
extern "C" void kernel_launch(void* const* d_in, const int* in_sizes, int n_in, void* d_out, int out_size, void* d_ws, size_t ws_size, hipStream_t stream) {
    static int grid = 0;
    if (grid == 0) {
        if (n_in != 23 || out_size != MTOK * DM || ws_size < WS_END) { fprintf(stderr, "kernel_launch: unexpected shapes (n_in %d out %d ws %zu)\n", n_in, out_size, ws_size); grid = -1; return; }
        int dev = 0, cus = 0, per_cu = 0;
        (void)hipGetDevice(&dev);
        (void)hipDeviceGetAttribute(&cus, hipDeviceAttributeMultiprocessorCount, dev);
        if (hipFuncSetAttribute((const void*)mega_fwd, hipFuncAttributeMaxDynamicSharedMemorySize, LDS_BYTES) != hipSuccess) { fprintf(stderr, "kernel_launch: hipFuncSetAttribute failed\n"); grid = -1; return; }
        if (hipOccupancyMaxActiveBlocksPerMultiprocessor(&per_cu, (const void*)mega_fwd, 512, LDS_BYTES) != hipSuccess || per_cu < 1) { fprintf(stderr, "kernel_launch: occupancy query says %d\n", per_cu); per_cu = 1; }
        (void)hipGetLastError();
        grid = cus * per_cu;
    }
    if (grid < 0) return;
    (void)hipMemsetAsync((char*)d_ws + WS_CTL, 0, CTL_BYTES, stream);
    Args a{};
    for (int i = 0; i < 23; ++i) a.in[i] = (const float*)d_in[i];
    a.out = (float*)d_out; a.ws = (unsigned char*)d_ws;
#if N_LAUNCH_SPLIT
    for (int p = 0; p < NPH; ++p) {
        a.ph_lo = p; a.ph_hi = p + 1;
        void* args[] = {&a};
        hipError_t e = hipLaunchCooperativeKernel((const void*)mega_fwd, dim3(grid), dim3(512), args, LDS_BYTES, stream);
        if (e != hipSuccess) { fprintf(stderr, "cooperative launch failed: %s (grid %d)\n", hipGetErrorString(e), grid); break; }
    }
#else
    a.ph_lo = 0; a.ph_hi = NPH;
    void* args[] = {&a};
    hipError_t e = hipLaunchCooperativeKernel((const void*)mega_fwd, dim3(grid), dim3(512), args, LDS_BYTES, stream);
    if (e != hipSuccess) fprintf(stderr, "cooperative launch failed: %s (grid %d)\n", hipGetErrorString(e), grid);
#endif
}
```

```cpp
#include <hip/hip_runtime.h>
#include <hip/hip_cooperative_groups.h>
#include <cstdio>
#include <cstdint>
namespace cg = cooperative_groups;

#define LAS __attribute__((address_space(3)))
typedef unsigned short bf16_t;
typedef short bf16x8 __attribute__((ext_vector_type(8)));
typedef short s16x4 __attribute__((ext_vector_type(4)));
typedef short v4i16_t __attribute__((ext_vector_type(4)));
typedef float f32x4 __attribute__((ext_vector_type(4)));
typedef float f32x2 __attribute__((ext_vector_type(2)));
typedef unsigned u32x4 __attribute__((ext_vector_type(4)));
typedef unsigned u32x2 __attribute__((ext_vector_type(2)));
typedef __bf16 bf16x2_t __attribute__((ext_vector_type(2)));

#define LOG2E 1.4426950408889634f
#define LN2F 0.6931471805599453f
#define QSCALE 0.18033688011112042f

__device__ __forceinline__ unsigned pk2(float lo, float hi) { f32x2 v = {lo, hi}; bf16x2_t b = __builtin_convertvector(v, bf16x2_t); return __builtin_bit_cast(unsigned, b); }
__device__ __forceinline__ unsigned short f2bf(float f) { return (unsigned short)(pk2(f, 0.f) & 0xffffu); }
__device__ __forceinline__ float bf2f(unsigned short h) { return __uint_as_float(((unsigned)h) << 16); }
__device__ __forceinline__ float bflo(unsigned w) { return __uint_as_float(w << 16); }
__device__ __forceinline__ float bfhi(unsigned w) { return __uint_as_float(w & 0xffff0000u); }
__device__ __forceinline__ float fexp2(float x) { return __builtin_amdgcn_exp2f(x); }
__device__ __forceinline__ float flog2(float x) { return __builtin_amdgcn_logf(x); }
__device__ __forceinline__ float frcp(float x) { return __builtin_amdgcn_rcpf(x); }
__device__ __forceinline__ float sigmoidf_(float x) { return frcp(1.f + fexp2(-LOG2E * x)); }
__device__ __forceinline__ float siluf_(float x) { return x * frcp(1.f + fexp2(-LOG2E * x)); }
__device__ __forceinline__ f32x4 mfma16(bf16x8 a, bf16x8 b, f32x4 c) { return __builtin_amdgcn_mfma_f32_16x16x32_bf16(a, b, c, 0, 0, 0); }
__device__ __forceinline__ s16x4 ldtr(const LAS unsigned char* p) { return __builtin_bit_cast(s16x4, __builtin_amdgcn_ds_read_tr16_b64_v4i16((LAS v4i16_t*)p)); }
__device__ __forceinline__ bf16x8 cat8(s16x4 a, s16x4 b) { bf16x8 r; r[0] = a[0]; r[1] = a[1]; r[2] = a[2]; r[3] = a[3]; r[4] = b[0]; r[5] = b[1]; r[6] = b[2]; r[7] = b[3]; return r; }
__device__ __forceinline__ bf16x8 pack8(f32x4 a, f32x4 b) { u32x4 w; w.x = pk2(a[0], a[1]); w.y = pk2(a[2], a[3]); w.z = pk2(b[0], b[1]); w.w = pk2(b[2], b[3]); return __builtin_bit_cast(bf16x8, w); }
__device__ __forceinline__ float wave_sum(float v) {
#pragma unroll
    for (int o = 1; o < 64; o <<= 1) v += __shfl_xor(v, o);
    return v;
}

namespace pg8 {
#define PG8_LAS __attribute__((address_space(3)))
typedef unsigned short bf16_t;
typedef short bf16x8 __attribute__((ext_vector_type(8)));
typedef float f32x4 __attribute__((ext_vector_type(4)));
typedef unsigned u32x4 __attribute__((ext_vector_type(4)));
constexpr int BM = 256, BK = 64, HALF = 128, HTB = HALF * BK * 2  , STAGE_BYTES = 8 * HTB, NXCD = 8, WGM = 4;

__host__ __device__ __forceinline__ int lds_byte(int r, int c) { const int st = (r >> 4) * 2 + (c >> 5), rr = r & 15, cc = c & 31, ob = rr * 64 + cc * 2; return st * 1024 + (ob ^ (((ob >> 9) & 1) << 5)); }
__host__ __device__ __forceinline__ void stage_rc(int b, int& R, int& C) { const int st = b / 1024, sb = b % 1024, swz = sb ^ (((sb >> 9) & 1) << 5); R = (st >> 1) * 16 + swz / 64; C = (st & 1) * 32 + (swz % 64) / 2; }
__host__ __device__ __forceinline__ int perm32(int rho) { const int n = rho >> 4, i = rho & 15; return 8 * (i >> 2) + 4 * n + (i & 3); }

struct Unit { int pm, pn; };
struct Gemm { const bf16_t* A; const bf16_t* Bt; int M, N, K; };

struct StaticOrder {
    int nM, nN, nwg, G, c;
    __host__ __device__ void init(int M, int N, int G_, int c_) { nM = M / BM; nN = N / BM; nwg = nM * nN; G = G_; c = c_; }
    __host__ __device__ bool next(int i, Unit& u) const {
        const long L = (long)i * G + c; if (L >= nwg) return false;
        int wgid = (int)L; { const int q = nwg / NXCD, r = nwg % NXCD, xcd = wgid % NXCD, off = wgid / NXCD; wgid = (xcd < r ? xcd * (q + 1) : r * (q + 1) + (xcd - r) * q) + off; }
        const int nig = WGM * nN, gid = wgid / nig, fm = gid * WGM, gsz = (nM - fm) < WGM ? (nM - fm) : WGM;
        u.pm = fm + ((wgid % nig) % gsz); u.pn = (wgid % nig) / gsz; return true;
    }
    __device__ __forceinline__ void a_ready(const Unit&) const {}
    __device__ __forceinline__ void done(const Unit&) const {}
};

typedef unsigned u32x2v __attribute__((ext_vector_type(2)));
struct EpiGU {
    static constexpr bool PERM = true, AFTER_DRAIN = false, HOOK = false;
    bf16_t* O; int ldo; const unsigned* RS;
    __device__ __forceinline__ void operator()(const f32x4 (&acc)[2][2][4][2], const Unit& u, int wr, int wc, int fr, int fq) const {
        const int row0 = u.pm * BM + wr * 64 + fr, col0 = u.pn * 128 + wc * 32 + 8 * fq;
        float rsv[2][4];
#pragma unroll
        for (int ai = 0; ai < 2; ++ai)
#pragma unroll
            for (int m = 0; m < 4; ++m) rsv[ai][m] = (float)RS[row0 + ai * HALF + m * 16] * (1.f / 1024.f);
#pragma unroll
        for (int ai = 0; ai < 2; ++ai)
#pragma unroll
            for (int mp = 0; mp < 2; ++mp) {
                float g[16], uu[16], e[16];
#pragma unroll
                for (int h = 0; h < 2; ++h) {
                    const int m = 2 * mp + h;
                    const float rs = __builtin_amdgcn_rsqf(rsv[ai][m] * (1.f / 1024.f) + 1e-6f);
#pragma unroll
                    for (int j = 0; j < 4; ++j) { g[8 * h + j] = acc[ai][0][m][0][j] * rs; g[8 * h + 4 + j] = acc[ai][0][m][1][j] * rs; uu[8 * h + j] = acc[ai][1][m][0][j] * rs; uu[8 * h + 4 + j] = acc[ai][1][m][1][j] * rs; }
                }
                __builtin_amdgcn_sched_barrier(0);
#pragma unroll
                for (int i = 0; i < 16; ++i) e[i] = ::fexp2(-LOG2E * g[i]);
                __builtin_amdgcn_sched_barrier(0);
#pragma unroll
                for (int i = 0; i < 16; ++i) e[i] = ::frcp(1.f + e[i]);
                __builtin_amdgcn_sched_barrier(0);
#pragma unroll
                for (int i = 0; i < 16; ++i) g[i] = g[i] * e[i] * uu[i];
#pragma unroll
                for (int h = 0; h < 2; ++h) {
                    bf16_t* rowp = O + (size_t)(row0 + ai * HALF + (2 * mp + h) * 16) * ldo + col0;
                    u32x4 w; w.x = ::pk2(g[8 * h + 0], g[8 * h + 1]); w.y = ::pk2(g[8 * h + 2], g[8 * h + 3]); w.z = ::pk2(g[8 * h + 4], g[8 * h + 5]); w.w = ::pk2(g[8 * h + 6], g[8 * h + 7]);
                    *(u32x4*)rowp = w;
                }
            }
    }
};
struct EpiRes {
    static constexpr bool PERM = true, AFTER_DRAIN = false, HOOK = false;
    const float* Rf; bf16_t* X; unsigned* RS; long long half_;
    __device__ __forceinline__ void operator()(const f32x4 (&acc)[2][2][4][2], const Unit& u, int wr, int wc, int fr, int fq) const {
        const int row0 = u.pm * BM + wr * 64 + fr, col0 = u.pn * BM + wc * 32 + 8 * fq;
        const float* const Rf = this->Rf; bf16_t* const X = this->X; const float scale = this->half_ ? 0.5f : 1.0f; unsigned* const RS = this->RS;
        f32x4 rv[2][2], rn[2][2];
        float ssv[8];
#define EPIRES_LOAD(dst, off_) do { _Pragma("unroll") for (int bj = 0; bj < 2; ++bj) { const size_t p_ = (off_) + bj * HALF; \
            if (Rf) { dst[bj][0] = *(const f32x4*)(Rf + p_); dst[bj][1] = *(const f32x4*)(Rf + p_ + 4); } \
            else { const u32x4 w_ = *(const u32x4*)(X + p_); dst[bj][0] = (f32x4){::bflo(w_.x), ::bfhi(w_.x), ::bflo(w_.y), ::bfhi(w_.y)}; dst[bj][1] = (f32x4){::bflo(w_.z), ::bfhi(w_.z), ::bflo(w_.w), ::bfhi(w_.w)}; } } } while (0)
        EPIRES_LOAD(rv, (size_t)row0 * 1024 + col0);
#pragma unroll
        for (int b = 0; b < 8; ++b) {
            const int ai = b >> 2, m = b & 3;
            const size_t off = (size_t)(row0 + ai * HALF + m * 16) * 1024 + col0;
            if (b < 7) EPIRES_LOAD(rn, (size_t)(row0 + ((b + 1) >> 2) * HALF + ((b + 1) & 3) * 16) * 1024 + col0);
            float ss = 0.f;
#pragma unroll
            for (int bj = 0; bj < 2; ++bj) {
                const f32x4 o0 = rv[bj][0] + acc[ai][bj][m][0] * scale, o1 = rv[bj][1] + acc[ai][bj][m][1] * scale;
                u32x4 w; w.x = ::pk2(o0[0], o0[1]); w.y = ::pk2(o0[2], o0[3]); w.z = ::pk2(o1[0], o1[1]); w.w = ::pk2(o1[2], o1[3]);
                *(u32x4*)(X + off + bj * HALF) = w;
                const float q0 = ::bflo(w.x), q1 = ::bfhi(w.x), q2 = ::bflo(w.y), q3 = ::bfhi(w.y), q4 = ::bflo(w.z), q5 = ::bfhi(w.z), q6 = ::bflo(w.w), q7 = ::bfhi(w.w);
                ss += ((q0 * q0 + q1 * q1) + (q2 * q2 + q3 * q3)) + ((q4 * q4 + q5 * q5) + (q6 * q6 + q7 * q7));
            }
            ssv[b] = ss;
#pragma unroll
            for (int bj = 0; bj < 2; ++bj)
#pragma unroll
                for (int n = 0; n < 2; ++n) rv[bj][n] = rn[bj][n];
        }
#pragma unroll
        for (int b = 0; b < 8; ++b) ssv[b] += __shfl_xor(ssv[b], 16);
#pragma unroll
        for (int b = 0; b < 8; ++b) ssv[b] += __shfl_xor(ssv[b], 32);
        if (fq == 0) {
#pragma unroll
            for (int b = 0; b < 8; ++b) atomicAdd(RS + row0 + (b >> 2) * HALF + (b & 3) * 16, (unsigned)(ssv[b] * 1024.f + 0.5f));
        }
#undef EPIRES_LOAD
    }
};
struct EpiIn {
    static constexpr bool PERM = true, AFTER_DRAIN = false, HOOK = false;
    bf16_t *zA, *zB, *zC, *zG; const unsigned* RS;
    __device__ __forceinline__ void operator()(const f32x4 (&acc)[2][2][4][2], const Unit& u, int wr, int wc, int fr, int fq) const {
        const int pn = u.pn; bf16_t* base; int ld, ct; float sc = 1.f; bool sig = false;
        if (pn < 6) { base = zA; ld = 1536; ct = pn; if (ct < 2) sc = QSCALE; }
        else if (pn < 12) { base = zB; ld = 1536; ct = pn - 6; if (ct < 2) sc = QSCALE; }
        else if (pn < 22) { base = zC; ld = 2560; ct = pn - 12; }
        else { base = zG; ld = 3072; ct = pn - 22; sig = true; }
        const int row0 = u.pm * BM + wr * 64 + fr, col0 = ct * BM + wc * 32 + 8 * fq;
        float rsv[2][4];
#pragma unroll
        for (int ai = 0; ai < 2; ++ai)
#pragma unroll
            for (int m = 0; m < 4; ++m) rsv[ai][m] = (float)RS[row0 + ai * HALF + m * 16] * (1.f / 1024.f);
#pragma unroll
        for (int ai = 0; ai < 2; ++ai)
#pragma unroll
            for (int m = 0; m < 4; ++m) {
                bf16_t* rowp = base + (size_t)(row0 + ai * HALF + m * 16) * ld + col0;
                const float rs = __builtin_amdgcn_rsqf(rsv[ai][m] * (1.f / 1024.f) + 1e-6f);
#pragma unroll
                for (int bj = 0; bj < 2; ++bj) {
                    f32x4 v0 = acc[ai][bj][m][0] * rs, v1 = acc[ai][bj][m][1] * rs;
                    if (sig) {
                        float e[8];
                        __builtin_amdgcn_sched_barrier(0);
#pragma unroll
                        for (int j = 0; j < 4; ++j) { e[j] = ::fexp2(-LOG2E * v0[j]); e[4 + j] = ::fexp2(-LOG2E * v1[j]); }
                        __builtin_amdgcn_sched_barrier(0);
#pragma unroll
                        for (int j = 0; j < 8; ++j) e[j] = ::frcp(1.f + e[j]);
                        __builtin_amdgcn_sched_barrier(0);
#pragma unroll
                        for (int j = 0; j < 4; ++j) { v0[j] = e[j]; v1[j] = e[4 + j]; }
                    } else { v0 = v0 * sc; v1 = v1 * sc; }
                    u32x4 w; w.x = ::pk2(v0[0], v0[1]); w.y = ::pk2(v0[2], v0[3]); w.z = ::pk2(v1[0], v1[1]); w.w = ::pk2(v1[2], v1[3]);
                    *(u32x4*)(rowp + bj * HALF) = w;
                }
            }
    }
};
struct EpiBr {
    static constexpr bool PERM = true, AFTER_DRAIN = false, HOOK = true;
    const bf16_t* G; bf16_t* Bo;
    static __device__ __forceinline__ void unpack8(u32x4 w, f32x4& a, f32x4& b) { a = (f32x4){::bflo(w.x), ::bfhi(w.x), ::bflo(w.y), ::bfhi(w.y)}; b = (f32x4){::bflo(w.z), ::bfhi(w.z), ::bflo(w.w), ::bfhi(w.w)}; }
    __device__ __forceinline__ void mid(f32x4 (&acc)[2][2][4][2], const Unit& u, int seg, int wr, int wc, int fr, int fq) const {
        const int row0 = u.pm * BM + wr * 64 + fr, col0 = u.pn * BM + wc * 32 + 8 * fq;
        const bf16_t* const Gn = G + (seg - 1) * 1024;
#pragma unroll
        for (int ai = 0; ai < 2; ++ai)
#pragma unroll
            for (int m = 0; m < 4; ++m) {
                const size_t r = (size_t)(row0 + ai * HALF + m * 16);
                u32x4 gn[2], gd[2];
#pragma unroll
                for (int bj = 0; bj < 2; ++bj) { gn[bj] = *(const u32x4*)(Gn + r * 3072 + col0 + bj * HALF); gd[bj] = *(const u32x4*)(Gn + r * 3072 + 1024 + col0 + bj * HALF); }
                f32x4 rt[2][2];
                __builtin_amdgcn_sched_barrier(0);
#pragma unroll
                for (int bj = 0; bj < 2; ++bj) {
                    f32x4 a0, a1, d0, d1; unpack8(gn[bj], a0, a1); unpack8(gd[bj], d0, d1);
#pragma unroll
                    for (int j = 0; j < 4; ++j) { rt[bj][0][j] = fmaxf(a0[j], 1e-30f) * ::frcp(fmaxf(d0[j], 1e-30f)); rt[bj][1][j] = fmaxf(a1[j], 1e-30f) * ::frcp(fmaxf(d1[j], 1e-30f)); }
                }
                __builtin_amdgcn_sched_barrier(0);
#pragma unroll
                for (int bj = 0; bj < 2; ++bj) { acc[ai][bj][m][0] = acc[ai][bj][m][0] * rt[bj][0]; acc[ai][bj][m][1] = acc[ai][bj][m][1] * rt[bj][1]; }
            }
    }
    __device__ __forceinline__ void operator()(const f32x4 (&acc)[2][2][4][2], const Unit& u, int wr, int wc, int fr, int fq) const {
        const int row0 = u.pm * BM + wr * 64 + fr, col0 = u.pn * BM + wc * 32 + 8 * fq;
#pragma unroll
        for (int ai = 0; ai < 2; ++ai)
#pragma unroll
            for (int m = 0; m < 4; ++m) {
                const size_t r = (size_t)(row0 + ai * HALF + m * 16);
                u32x4 gv[2];
#pragma unroll
                for (int bj = 0; bj < 2; ++bj) gv[bj] = *(const u32x4*)(G + r * 3072 + 2048 + col0 + bj * HALF);
#pragma unroll
                for (int bj = 0; bj < 2; ++bj) {
                    f32x4 g0, g1; unpack8(gv[bj], g0, g1);
                    f32x4 v0 = acc[ai][bj][m][0], v1 = acc[ai][bj][m][1];
#pragma unroll
                    for (int j = 0; j < 4; ++j) { v0[j] *= fmaxf(g0[j], 1e-30f); v1[j] *= fmaxf(g1[j], 1e-30f); }
                    u32x4 w; w.x = ::pk2(v0[0], v0[1]); w.y = ::pk2(v0[2], v0[3]); w.z = ::pk2(v1[0], v1[1]); w.w = ::pk2(v1[2], v1[3]);
                    *(u32x4*)(Bo + r * 1024 + col0 + bj * HALF) = w;
                }
            }
    }
};
template <class Epi, class Sched, bool ALIGN_EPI = false, bool SP2 = false>
__device__ __forceinline__ void gemm_phase(PG8_LAS unsigned char* lds, const Gemm g, const Sched& S, const Epi& E) {
    int tid_l = threadIdx.x; asm volatile("" : "+v"(tid_l)); const int tid = tid_l, wid = __builtin_amdgcn_readfirstlane(tid >> 6), lane = tid & 63, wr = wid >> 2, wc = wid & 3, fr = lane & 15, fq = lane >> 4;
    const int K = g.K, nt = K / BK;
    unsigned voffA[2], voffB[2];
#pragma unroll
    for (int i = 0; i < 2; ++i) { int R, C; stage_rc(tid * 16 + i * 8192, R, C); const int Rb = Epi::PERM ? ((R & ~31) + perm32(R & 31)) : R;
        voffA[i] = (unsigned)(R * K + C) * 2u; voffB[i] = (unsigned)(Rb * K + C) * 2u; }
    const size_t kstep = (size_t)(BK * 2);
    const size_t hstep = (size_t)HALF * K * 2;
    const size_t tstep = 2 * hstep;
    const unsigned ldsw = (unsigned)wid * 1024u;
    const int aoff = lds_byte(wr * 64 + fr, fq * 8), boff = lds_byte(wc * 32 + fr, fq * 8);
#define PG8_SA(b, h) (((b) * 2 + (h)) * HTB)
#define PG8_SB(b, h) ((4 + (b) * 2 + (h)) * HTB)
#define PG8_STAGE(bufoff, gbase, voff) do { _Pragma("unroll") for (int _i = 0; _i < 2; ++_i) \
        __builtin_amdgcn_global_load_lds((const unsigned*)((const char*)(gbase) + (voff)[_i]), (PG8_LAS unsigned*)(lds + (bufoff) + ldsw + _i * 8192), 16, 0, 0); } while (0)
#define PG8_LDA(dst, b, h) do { _Pragma("unroll") for (int m = 0; m < 4; ++m) _Pragma("unroll") for (int k = 0; k < 2; ++k) dst[m][k] = *(const PG8_LAS bf16x8*)(lds + PG8_SA(b, h) + aoff + m * 2048 + k * 1024); } while (0)
#define PG8_LDB(dst, b, h) do { _Pragma("unroll") for (int n = 0; n < 2; ++n) _Pragma("unroll") for (int k = 0; k < 2; ++k) dst[n][k] = *(const PG8_LAS bf16x8*)(lds + PG8_SB(b, h) + boff + n * 2048 + k * 1024); } while (0)
#define PG8_MMA(ai, bj, At, Bt) do { __builtin_amdgcn_s_setprio(1); _Pragma("unroll") for (int m = 0; m < 4; ++m) _Pragma("unroll") for (int n = 0; n < 2; ++n) _Pragma("unroll") for (int k = 0; k < 2; ++k) \
        acc[ai][bj][m][n] = __builtin_amdgcn_mfma_f32_16x16x32_bf16(Bt[n][k], At[m][k], acc[ai][bj][m][n], 0, 0, 0); __builtin_amdgcn_s_setprio(0); } while (0)
#define PG8_WAIT_V(n) asm volatile("s_waitcnt vmcnt(" #n ")" ::: "memory")
#define PG8_WAIT_L(n) asm volatile("s_waitcnt lgkmcnt(" #n ")" ::: "memory")
#define PG8_BAR __builtin_amdgcn_s_barrier()
#define PG8_SCHED __builtin_amdgcn_sched_barrier(0)
    Unit cur, nxt; int ui = 0;
    if (!S.next(0, cur)) return;
    f32x4 acc[2][2][4][2];
#pragma unroll
    for (int a = 0; a < 2; ++a)
#pragma unroll
        for (int b = 0; b < 2; ++b)
#pragma unroll
            for (int m = 0; m < 4; ++m)
#pragma unroll
                for (int n = 0; n < 2; ++n) acc[a][b][m][n] = (f32x4){0.f, 0.f, 0.f, 0.f};
    bf16x8 At[4][2], B0[2][2], B1[2][2];
    const char* cA = (const char*)g.A + (size_t)cur.pm * tstep; const char* cB = (const char*)g.Bt + (size_t)cur.pn * tstep;
    S.a_ready(cur);
    if constexpr (SP2) {
        PG8_STAGE(PG8_SB(0, 0), cB, voffB); PG8_STAGE(PG8_SB(0, 1), cB + hstep, voffB); PG8_STAGE(PG8_SA(0, 0), cA, voffA); PG8_STAGE(PG8_SA(0, 1), cA + hstep, voffA);
        if (wr == 1) PG8_BAR;
        PG8_WAIT_V(2); PG8_BAR;
        PG8_STAGE(PG8_SB(1, 0), cB + kstep, voffB); PG8_STAGE(PG8_SA(1, 0), cA + kstep, voffA); PG8_STAGE(PG8_SB(1, 1), cB + hstep + kstep, voffB);
        PG8_WAIT_V(6); PG8_BAR;
    } else {
        PG8_STAGE(PG8_SB(0, 0), cB, voffB); PG8_STAGE(PG8_SA(0, 0), cA, voffA); PG8_STAGE(PG8_SB(0, 1), cB + hstep, voffB); PG8_STAGE(PG8_SA(0, 1), cA + hstep, voffA);
        if (wr == 1) PG8_BAR;
        PG8_WAIT_V(4); PG8_BAR;
        PG8_STAGE(PG8_SB(1, 0), cB + kstep, voffB); PG8_STAGE(PG8_SA(1, 0), cA + kstep, voffA); PG8_STAGE(PG8_SB(1, 1), cB + hstep + kstep, voffB);
        PG8_WAIT_V(6); PG8_BAR;
    }
    for (;;) {
        const bool has_next = S.next(ui + 1, nxt);
        const char* nA = has_next ? (const char*)g.A + (size_t)nxt.pm * tstep : cA; const char* nB = has_next ? (const char*)g.Bt + (size_t)nxt.pn * tstep : cB;
        for (int t = 0; t < nt; t += 2) {
            if constexpr (Epi::HOOK) { if (t == 8 || t == 16) E.mid(acc, cur, t >> 3, wr, wc, fr, fq); }
            const bool last = (t == nt - 2);
            const char* a1 = cA + (size_t)(t + 1) * kstep;
            const char* a2 = last ? nA : cA + (size_t)(t + 2) * kstep; const char* b2 = last ? nB : cB + (size_t)(t + 2) * kstep;
            const char* a3 = a2 + kstep; const char* b3 = b2 + kstep;
            if (last && has_next) S.a_ready(nxt);
            if constexpr (SP2) {
            PG8_LDB(B0, 0, 0); PG8_LDB(B1, 0, 1); PG8_SCHED; PG8_LDA(At, 0, 0); PG8_STAGE(PG8_SA(1, 1), a1 + hstep, voffA);
            PG8_WAIT_V(8); PG8_WAIT_L(0); PG8_BAR; PG8_MMA(0, 0, At, B0); PG8_MMA(0, 1, At, B1); PG8_BAR; PG8_SCHED;
            PG8_LDA(At, 0, 1); PG8_STAGE(PG8_SB(0, 0), b2, voffB); PG8_STAGE(PG8_SB(0, 1), b2 + hstep, voffB); PG8_STAGE(PG8_SA(0, 0), a2, voffA);
            PG8_WAIT_V(8); PG8_WAIT_L(0); PG8_BAR; PG8_MMA(1, 0, At, B0); PG8_MMA(1, 1, At, B1); PG8_BAR; PG8_SCHED;
            PG8_LDB(B0, 1, 0); PG8_LDB(B1, 1, 1); PG8_SCHED; PG8_LDA(At, 1, 0); PG8_STAGE(PG8_SA(0, 1), a2 + hstep, voffA);
            PG8_WAIT_V(8); PG8_WAIT_L(0); PG8_BAR; PG8_MMA(0, 0, At, B0); PG8_MMA(0, 1, At, B1); PG8_BAR; PG8_SCHED;
            PG8_LDA(At, 1, 1); PG8_STAGE(PG8_SB(1, 0), b3, voffB); PG8_STAGE(PG8_SB(1, 1), b3 + hstep, voffB); PG8_STAGE(PG8_SA(1, 0), a3, voffA);
            PG8_WAIT_V(8); PG8_WAIT_L(0); PG8_BAR; PG8_MMA(1, 0, At, B0); PG8_MMA(1, 1, At, B1); PG8_BAR; PG8_SCHED;
            } else {
            PG8_LDB(B0, 0, 0); PG8_SCHED; PG8_LDA(At, 0, 0); PG8_STAGE(PG8_SA(1, 1), a1 + hstep, voffA);
            PG8_WAIT_L(8); PG8_BAR; PG8_WAIT_L(0); PG8_MMA(0, 0, At, B0); PG8_BAR; PG8_SCHED;
            PG8_LDB(B1, 0, 1); PG8_STAGE(PG8_SB(0, 0), b2, voffB);
            PG8_BAR; PG8_WAIT_L(0); PG8_MMA(0, 1, At, B1); PG8_BAR;
            PG8_LDA(At, 0, 1); PG8_STAGE(PG8_SA(0, 0), a2, voffA);
            PG8_BAR; PG8_WAIT_L(0); PG8_MMA(1, 0, At, B0); PG8_BAR; PG8_SCHED;
            PG8_STAGE(PG8_SB(0, 1), b2 + hstep, voffB);
            PG8_WAIT_V(6); PG8_BAR; PG8_MMA(1, 1, At, B1); PG8_BAR;
            PG8_LDB(B0, 1, 0); PG8_SCHED; PG8_LDA(At, 1, 0); PG8_STAGE(PG8_SA(0, 1), a2 + hstep, voffA);
            PG8_WAIT_L(8); PG8_BAR; PG8_WAIT_L(0); PG8_MMA(0, 0, At, B0); PG8_BAR; PG8_SCHED;
            PG8_LDB(B1, 1, 1); PG8_STAGE(PG8_SB(1, 0), b3, voffB);
            PG8_BAR; PG8_WAIT_L(0); PG8_MMA(0, 1, At, B1); PG8_BAR;
            PG8_LDA(At, 1, 1); PG8_STAGE(PG8_SA(1, 0), a3, voffA);
            PG8_BAR; PG8_WAIT_L(0); PG8_MMA(1, 0, At, B0); PG8_BAR; PG8_SCHED;
            PG8_STAGE(PG8_SB(1, 1), b3 + hstep, voffB);
            PG8_WAIT_V(6); PG8_BAR; PG8_MMA(1, 1, At, B1); PG8_BAR;
            }
        }
        if constexpr (ALIGN_EPI) { if (wr == 0) PG8_BAR; }
        if constexpr (!Epi::AFTER_DRAIN) { E(acc, cur, wr, wc, fr, fq); S.done(cur); }
        if (!has_next) break;
#pragma unroll
        for (int a = 0; a < 2; ++a)
#pragma unroll
            for (int b = 0; b < 2; ++b)
#pragma unroll
                for (int m = 0; m < 4; ++m)
#pragma unroll
                    for (int n = 0; n < 2; ++n) acc[a][b][m][n] = (f32x4){0.f, 0.f, 0.f, 0.f};
        cur = nxt; cA = nA; cB = nB; ++ui;
        if constexpr (ALIGN_EPI) { if (wr == 1) PG8_BAR; }
    }
    PG8_WAIT_V(0);
    if constexpr (!ALIGN_EPI) { if (wr == 0) PG8_BAR; }
    PG8_BAR;
    if constexpr (Epi::AFTER_DRAIN) { E.fused(acc, cur, wr, wc, fr, fq, lds, wid, lane); S.done(cur); }
#undef PG8_SA
#undef PG8_SB
#undef PG8_STAGE
#undef PG8_LDA
#undef PG8_LDB
#undef PG8_MMA
#undef PG8_WAIT_V
#undef PG8_WAIT_L
#undef PG8_BAR
#undef PG8_SCHED
}
}

constexpr int SEQ = 2048, NBATCH = 16, MTOK = NBATCH * SEQ, DM = 1024, DFF = 2816, DIN = 8704, MH = MTOK / 2, NBH = NBATCH / 2;
constexpr size_t MiB = 1u << 20;
constexpr size_t WS_CTL = 0, CTL_BYTES = 1u << 20, WS_RS = 65536;
constexpr int CW_BAR = 1024;
constexpr size_t WS_W = 1 * MiB;
constexpr size_t W_GU1 = 0, W_D1 = 11 * MiB, W_IN = W_D1 + 5767168, W_BA = W_IN + 17 * MiB, W_BB = W_BA + MiB, W_BC = W_BB + MiB, W_OUT = W_BC + MiB, W_GU2 = W_OUT + 2 * MiB, W_D2 = W_GU2 + 11 * MiB;
constexpr size_t WS_XN = 56 * MiB, WS_BIG = 120 * MiB;
constexpr size_t WS_ZA = WS_BIG, WS_ZB = WS_ZA + 48 * MiB, WS_ZC = WS_ZB + 48 * MiB, WS_ZG = WS_ZC + 80 * MiB;
constexpr size_t WS_MF = WS_BIG, WS_MB = WS_BIG + 64 * MiB;
constexpr size_t WS_YA = 392 * MiB, WS_YB = 408 * MiB, WS_YC = 424 * MiB, WS_OP = 440 * MiB, WS_LSE = 488 * MiB, WS_END = 490 * MiB;
static_assert(W_D2 + 5767168 <= 55 * MiB, "weights map");
constexpr int LDS_BYTES = 147456, LDS_CTRL = 140000;
constexpr int NPH = 35;
constexpr int NU_H = NBH * 4 * 2, NU_D = NBH * 4 * 16, NU_L = NBH * 8 * 3 * 4, NU_ALL = NU_H + NU_D + NU_L;

#ifndef PROBE_DUP_H
#define PROBE_DUP_H 0
#endif
#ifndef PROBE_DUP_A
#define PROBE_DUP_A 0
#endif
struct Args { const float* in[23]; float* out; unsigned char* ws; int ph_lo, ph_hi; };
typedef const __attribute__((address_space(4))) Args* ArgP;

__device__ __forceinline__ void transpose_item(const float* W, int N, int K, bf16_t* WT, const float* gain, int drow0, int k0, int n0, LAS float* scr, int lane, int ldk = 0, int koff = 0) {
    if (ldk == 0) ldk = K;
    const int c4 = lane & 15, kr = lane >> 4;
#pragma unroll 8
    for (int i = 0; i < 16; ++i) { const int kk = 4 * i + kr; const float gs = gain ? gain[k0 + kk] : 1.f; const f32x4 v = *(const f32x4*)(W + (size_t)(k0 + kk) * N + n0 + 4 * c4); *(LAS f32x4*)(scr + kk * 68 + 4 * c4) = v * gs; }
    asm volatile("s_waitcnt lgkmcnt(0)" ::: "memory");
    const int c = lane & 7;
#pragma unroll
    for (int j = 0; j < 8; ++j) { const int n = (lane >> 3) + 8 * j; const LAS float* s = scr + (8 * c) * 68 + n;
        u32x4 o; o.x = pk2(s[0 * 68], s[1 * 68]); o.y = pk2(s[2 * 68], s[3 * 68]); o.z = pk2(s[4 * 68], s[5 * 68]); o.w = pk2(s[6 * 68], s[7 * 68]);
        *(u32x4*)(WT + (size_t)(drow0 + n) * ldk + koff + k0 + 8 * c) = o; }
    asm volatile("s_waitcnt lgkmcnt(0)" ::: "memory");
}
__device__ __forceinline__ void tr_plain(const float* W, int K, int N, bf16_t* WT, const float* gain, int item, LAS float* scr, int lane, int ldk = 0, int koff = 0) {
    const int nblk = N / 64, kb = item / nblk, nb = item % nblk;
    transpose_item(W, N, K, WT, gain, nb * 64, kb * 64, nb * 64, scr, lane, ldk, koff);
}
__device__ __forceinline__ void tr_gu(const float* W, bf16_t* WT, const float* gain, int up, int item, LAS float* scr, int lane) {
    const int nblk = DFF / 64, kb = item / nblk, nb = item % nblk, n0 = nb * 64;
    transpose_item(W, DFF, DM, WT, gain, (n0 >> 7) * 256 + (n0 & 127) + up * 128, kb * 64, n0, scr, lane);
}
constexpr int PREP_NIT = 4 * ((DM / 64) * (DFF / 64)) + 2 * ((DFF / 64) * (DM / 64)) + (DM / 64) * (DIN / 64) + 3 * ((512 / 64) * (DM / 64)) + (DM / 64) * (DM / 64);
constexpr int PREP_EARLY = 3 * ((DM / 64) * (DFF / 64)) + (DM / 64) * (DIN / 64);
__device__ __forceinline__ void prep_weights(ArgP ap, int l, LAS unsigned char* lds, int tid, int gw, int NGW, int it_lo, int it_hi) {
    const int lane = tid & 63, wv = tid >> 6;
    LAS float* scr = (LAS float*)(lds + wv * 17408);
    unsigned char* wb = ap->ws + WS_W;
    constexpr int I_G = (DM / 64) * (DFF / 64), I_D = (DFF / 64) * (DM / 64), I_IN = (DM / 64) * (DIN / 64), I_B = (512 / 64) * (DM / 64), I_O = (DM / 64) * (DM / 64);
    static_assert(PREP_NIT == 4 * I_G + 2 * I_D + I_IN + 3 * I_B + I_O && PREP_EARLY == 2 * I_G + I_D + I_IN, "item counts");
    const size_t oGU = (size_t)l * DM * DFF, oD = (size_t)l * DFF * DM;
    for (int it = it_lo + gw; it < it_hi; it += NGW) {
        int r = it;
        if (r < I_G) { tr_gu(ap->in[2] + oGU, (bf16_t*)(wb + W_GU1), ap->in[1] + l * DM, 0, r, scr, lane); continue; } r -= I_G;
        if (r < I_G) { tr_gu(ap->in[3] + oGU, (bf16_t*)(wb + W_GU1), ap->in[1] + l * DM, 1, r, scr, lane); continue; } r -= I_G;
        if (r < I_D) { tr_plain(ap->in[4] + oD, DFF, DM, (bf16_t*)(wb + W_D1), nullptr, r, scr, lane); continue; } r -= I_D;
        if (r < I_IN) { tr_plain(ap->in[6] + (size_t)l * DM * DIN, DM, DIN, (bf16_t*)(wb + W_IN), ap->in[5] + l * DM, r, scr, lane); continue; } r -= I_IN;
        if (r < I_B) { tr_plain(ap->in[14] + (size_t)l * 512 * DM, 512, DM, (bf16_t*)(wb + W_BA), nullptr, r, scr, lane, 1536, 0); continue; } r -= I_B;
        if (r < I_B) { tr_plain(ap->in[15] + (size_t)l * 512 * DM, 512, DM, (bf16_t*)(wb + W_BA), nullptr, r, scr, lane, 1536, 512); continue; } r -= I_B;
        if (r < I_B) { tr_plain(ap->in[16] + (size_t)l * 512 * DM, 512, DM, (bf16_t*)(wb + W_BA), nullptr, r, scr, lane, 1536, 1024); continue; } r -= I_B;
        if (r < I_O) { tr_plain(ap->in[17] + (size_t)l * DM * DM, DM, DM, (bf16_t*)(wb + W_OUT), nullptr, r, scr, lane); continue; } r -= I_O;
        if (r < I_G) { tr_gu(ap->in[19] + oGU, (bf16_t*)(wb + W_GU2), ap->in[18] + l * DM, 0, r, scr, lane); continue; } r -= I_G;
        if (r < I_G) { tr_gu(ap->in[20] + oGU, (bf16_t*)(wb + W_GU2), ap->in[18] + l * DM, 1, r, scr, lane); continue; } r -= I_G;
        tr_plain(ap->in[21] + oD, DFF, DM, (bf16_t*)(wb + W_D2), nullptr, r, scr, lane);
    }
}

__device__ __forceinline__ void norm_rows(const float* src, bf16_t* xn, float* outf, const float* gain, unsigned* rs_out, int tid, int bid, int nbk) {
    const int lane = tid & 63, wv = tid >> 6;
    const int gw = bid * 8 + wv, NGW = nbk * 8;
    for (int m = gw; m < MTOK; m += NGW) {
        const float* xr = src + (size_t)m * DM + lane * 8;
        f32x4 v[4]; float s = 0.f;
#pragma unroll
        for (int j = 0; j < 4; ++j) { v[j] = *(const f32x4*)(xr + (j >> 1) * 512 + (j & 1) * 4); s += (v[j][0] * v[j][0] + v[j][1] * v[j][1]) + (v[j][2] * v[j][2] + v[j][3] * v[j][3]); }
        const float tot = wave_sum(s);
        if (rs_out && lane == 0) rs_out[m] = (unsigned)(tot * 1024.f + 0.5f);
        bf16_t* o = xn + (size_t)m * DM + lane * 8;
#pragma unroll
        for (int hh = 0; hh < 2; ++hh) { u32x4 w; w.x = pk2(v[2 * hh][0], v[2 * hh][1]); w.y = pk2(v[2 * hh][2], v[2 * hh][3]); w.z = pk2(v[2 * hh + 1][0], v[2 * hh + 1][1]); w.w = pk2(v[2 * hh + 1][2], v[2 * hh + 1][3]); *(u32x4*)(o + hh * 512) = w; }
    }
}
__device__ __forceinline__ void final_norm_rows(const bf16_t* xb, float* outf, const float* gain, int tid, int bid, int nbk) {
    const int lane = tid & 63, wv = tid >> 6;
    const int gw = bid * 8 + wv, NGW = nbk * 8;
    for (int m = gw; m < MTOK; m += NGW) {
        const bf16_t* xr = xb + (size_t)m * DM + lane * 8;
        const u32x4 a = *(const u32x4*)xr, b = *(const u32x4*)(xr + 512);
        float v[16];
        v[0] = bflo(a.x); v[1] = bfhi(a.x); v[2] = bflo(a.y); v[3] = bfhi(a.y); v[4] = bflo(a.z); v[5] = bfhi(a.z); v[6] = bflo(a.w); v[7] = bfhi(a.w);
        v[8] = bflo(b.x); v[9] = bfhi(b.x); v[10] = bflo(b.y); v[11] = bfhi(b.y); v[12] = bflo(b.z); v[13] = bfhi(b.z); v[14] = bflo(b.w); v[15] = bfhi(b.w);
        float s = 0.f;
#pragma unroll
        for (int i = 0; i < 16; ++i) s += v[i] * v[i];
        const float r = 1.0f / sqrtf(wave_sum(s) * (1.f / DM) + 1e-6f);
        float* o = outf + (size_t)m * DM + lane * 8; const float* g = gain + lane * 8;
#pragma unroll
        for (int hh = 0; hh < 2; ++hh)
#pragma unroll
            for (int q = 0; q < 2; ++q) { const f32x4 gg = *(const f32x4*)(g + hh * 512 + q * 4); f32x4 ov; ov[0] = v[hh * 8 + q * 4 + 0] * r * gg[0]; ov[1] = v[hh * 8 + q * 4 + 1] * r * gg[1]; ov[2] = v[hh * 8 + q * 4 + 2] * r * gg[2]; ov[3] = v[hh * 8 + q * 4 + 3] * r * gg[3]; *(f32x4*)(o + hh * 512 + q * 4) = ov; }
    }
}

template <int DVT, int NKB, bool MASKED, bool EDGE = true>
__device__ __forceinline__ void attn_step(const LAS unsigned char* kbase, int kstr, const LAS unsigned char* vbase, int vstr, bf16x8 q0, bf16x8 q1,
                                          f32x4 (&o)[DVT], float& m, float& l, float relq, float nslope, int kidx0, int klim, int tid) {
    const int lane = tid & 63, fr = lane & 15, quad = lane >> 4;
    f32x4 s[NKB][2];
    float mx = -1e30f;
#pragma unroll
    for (int nb = 0; nb < NKB; ++nb)
#pragma unroll
        for (int t = 0; t < 2; ++t) {
            const LAS unsigned char* kp = kbase + (nb * 32 + t * 16 + fr) * kstr + quad * 16;
            const bf16x8 k0 = *(const LAS bf16x8*)kp, k1 = *(const LAS bf16x8*)(kp + 64);
            const bool DEAD = MASKED && NKB == 5 && nb == 4 && t == 1;
            const bool BAND = MASKED && (NKB != 5 || (nb == 0 && t == 0) || nb == 4);
            f32x4 acc = {0.f, 0.f, 0.f, 0.f};
            if (DEAD) { acc = (f32x4){-1e30f, -1e30f, -1e30f, -1e30f}; }
            else {
#pragma unroll
                for (int j = 0; j < 4; ++j) acc[j] = nslope * __builtin_fabsf(relq - (float)(nb * 32 + t * 16 + j));
                acc = mfma16(k0, q0, acc); acc = mfma16(k1, q1, acc);
#pragma unroll
                for (int j = 0; j < 4; ++j) {
                    const float rel = relq - (float)(nb * 32 + t * 16 + j);
                    float v = acc[j];
                    if (MASKED) {
                        bool ok = true;
                        if (BAND) ok = (__builtin_fabsf(rel) <= 64.f);
                        if (EDGE) { const int kidx = kidx0 + nb * 32 + t * 16 + quad * 4 + j; ok = ok && (kidx >= 0) && (kidx < klim); }
                        if (BAND || EDGE) v = ok ? v : -1e30f;
                    }
                    acc[j] = v; mx = fmaxf(mx, v);
                }
            }
            s[nb][t] = acc;
        }
    mx = fmaxf(mx, __shfl_xor(mx, 16)); mx = fmaxf(mx, __shfl_xor(mx, 32));
    const float mn = fmaxf(m, mx), alpha = fexp2(m - mn);
    m = mn;
    float ps = 0.f;
#pragma unroll
    for (int nb = 0; nb < NKB; ++nb)
#pragma unroll
        for (int t = 0; t < 2; ++t)
#pragma unroll
            for (int j = 0; j < 4; ++j) { const float p = fexp2(s[nb][t][j] - mn); s[nb][t][j] = p; ps += p; }
    l = l * alpha + ps;
#pragma unroll
    for (int d = 0; d < DVT; ++d) o[d] = o[d] * alpha;
#pragma unroll
    for (int nb = 0; nb < NKB; ++nb) {
        const bf16x8 pf = pack8(s[nb][0], s[nb][1]);
        const LAS unsigned char* vp = vbase + (nb * 32 + quad * 4 + (fr >> 2)) * vstr + (fr & 3) * 8;
#pragma unroll
        for (int d = 0; d < DVT; ++d) {
            const bool dead1 = MASKED && NKB == 5 && nb == 4;
            const s16x4 v0 = ldtr(vp + d * 32), v1 = ldtr(vp + (dead1 ? 0 : 16 * vstr) + d * 32);
            o[d] = mfma16(cat8(v0, v1), pf, o[d]);
        }
    }
}

template <int DVT, int NKB>
__device__ __forceinline__ void attn_step2(const LAS unsigned char* kbase, int kstr, const LAS unsigned char* vbase, int vstr, bf16x8 qa0, bf16x8 qa1, bf16x8 qb0, bf16x8 qb1,
                                           f32x4 (&oa)[DVT], f32x4 (&ob)[DVT], float& ma, float& la, float& mb, float& lb, float relq, float nslope, int tid) {
    const int lane = tid & 63, fr = lane & 15, quad = lane >> 4;
    f32x4 sa[NKB][2], sb[NKB][2];
    float mxa = -1e30f, mxb = -1e30f;
#pragma unroll
    for (int nb = 0; nb < NKB; ++nb)
#pragma unroll
        for (int t = 0; t < 2; ++t) {
            const LAS unsigned char* kp = kbase + (nb * 32 + t * 16 + fr) * kstr + quad * 16;
            const bf16x8 k0 = *(const LAS bf16x8*)kp, k1 = *(const LAS bf16x8*)(kp + 64), k2 = *(const LAS bf16x8*)(kp + 128), k3 = *(const LAS bf16x8*)(kp + 192);
            f32x4 b4;
#pragma unroll
            for (int j = 0; j < 4; ++j) b4[j] = nslope * __builtin_fabsf(relq - (float)(nb * 32 + t * 16 + j));
            f32x4 aa = mfma16(k0, qa0, b4), ab = mfma16(k2, qb0, b4);
            aa = mfma16(k1, qa1, aa); ab = mfma16(k3, qb1, ab);
#pragma unroll
            for (int j = 0; j < 4; ++j) { mxa = fmaxf(mxa, aa[j]); mxb = fmaxf(mxb, ab[j]); }
            sa[nb][t] = aa; sb[nb][t] = ab;
        }
    if (!__any((mxa - ma > -140.f) || (mxb - mb > -140.f))) return;
    mxa = fmaxf(mxa, __shfl_xor(mxa, 16)); mxb = fmaxf(mxb, __shfl_xor(mxb, 16));
    mxa = fmaxf(mxa, __shfl_xor(mxa, 32)); mxb = fmaxf(mxb, __shfl_xor(mxb, 32));
    const float mna = fmaxf(ma, mxa), mnb = fmaxf(mb, mxb);
    if (__any((mna > ma) || (mnb > mb))) {
        const float ala = fexp2(ma - mna), alb = fexp2(mb - mnb);
        la *= ala; lb *= alb;
#pragma unroll
        for (int d = 0; d < DVT; ++d) { oa[d] = oa[d] * ala; ob[d] = ob[d] * alb; }
        ma = mna; mb = mnb;
    }
    float psa = 0.f, psb = 0.f;
#pragma unroll
    for (int nb = 0; nb < NKB; ++nb) {
#pragma unroll
        for (int t = 0; t < 2; ++t)
#pragma unroll
            for (int j = 0; j < 4; ++j) { const float pa = fexp2(sa[nb][t][j] - ma), pb = fexp2(sb[nb][t][j] - mb); sa[nb][t][j] = pa; sb[nb][t][j] = pb; psa += pa; psb += pb; }
        const bf16x8 pfa = pack8(sa[nb][0], sa[nb][1]), pfb = pack8(sb[nb][0], sb[nb][1]);
        const LAS unsigned char* vp = vbase + (nb * 32 + quad * 4 + (fr >> 2)) * vstr + (fr & 3) * 8;
        __builtin_amdgcn_s_setprio(1);
#pragma unroll
        for (int d = 0; d < DVT; ++d) {
            const bf16x8 vf = cat8(ldtr(vp + d * 32), ldtr(vp + 16 * vstr + d * 32));
            oa[d] = mfma16(vf, pfa, oa[d]); ob[d] = mfma16(vf, pfb, ob[d]);
        }
        __builtin_amdgcn_s_setprio(0);
    }
    la += psa; lb += psb;
}
constexpr int DA_KSTR = 272, DA_VSTR = 288, DA_KB = 64 * DA_KSTR, DA_BUF = DA_KB + 64 * DA_VSTR;
__device__ __forceinline__ int da_order(int i, int qt) {
    const int c = 2 * qt;
    if (i < 2) return c + i;
    const int j = i - 2, L = c, R = 30 - c, mn = L < R ? L : R;
    if (j < 2 * mn) return (j & 1) ? (c + 2 + (j >> 1)) : (c - 1 - (j >> 1));
    const int rem = j - 2 * mn;
    return (L > R) ? (c - 1 - mn - rem) : (c + 2 + mn + rem);
}
__device__ __forceinline__ void diff_unit(LAS unsigned char* lds, const bf16_t* zA, bf16_t* ya, int bl, int h, int qt, float slope, float lam, float oml, const float* subln, int tid) {
    const int lane = tid & 63, wv = __builtin_amdgcn_readfirstlane(tid >> 6), fr = lane & 15, quad = lane >> 4;
    const size_t rb = (size_t)bl * SEQ;
    const int qpos = qt * 128 + wv * 16 + fr;
    const bf16_t* qp = zA + (rb + qpos) * 1536 + h * 128 + quad * 8;
    const bf16x8 qa0 = *(const bf16x8*)qp, qa1 = *(const bf16x8*)(qp + 32), qb0 = *(const bf16x8*)(qp + 64), qb1 = *(const bf16x8*)(qp + 96);
    f32x4 oa[8], ob[8];
#pragma unroll
    for (int d = 0; d < 8; ++d) { oa[d] = (f32x4){0.f, 0.f, 0.f, 0.f}; ob[d] = (f32x4){0.f, 0.f, 0.f, 0.f}; }
    float ma = -1e30f, la = 0.f, mb = -1e30f, lb = 0.f;
    const float nslope = -slope * LOG2E;
    const int r0 = tid >> 4, ch = tid & 15;
    const bf16_t* kg = zA + (rb + r0) * 1536 + 512 + h * 128 + ch * 8;
    const bf16_t* vg = zA + (rb + r0) * 1536 + 1024 + h * 128 + ch * 8;
    u32x4 pk_[2], pv_[2];
    int ktile = da_order(0, qt);
#pragma unroll
    for (int j = 0; j < 2; ++j) { pk_[j] = *(const u32x4*)(kg + (size_t)(ktile * 64 + j * 32) * 1536); pv_[j] = *(const u32x4*)(vg + (size_t)(ktile * 64 + j * 32) * 1536); }
#pragma unroll
    for (int j = 0; j < 2; ++j) { *(LAS u32x4*)(lds + (r0 + j * 32) * DA_KSTR + ch * 16) = pk_[j]; *(LAS u32x4*)(lds + DA_KB + (r0 + j * 32) * DA_VSTR + ch * 16) = pv_[j]; }
    __syncthreads();
    for (int kt = 0; kt < 32; ++kt) {
        const int cb = (kt & 1) * DA_BUF, nb_ = ((kt + 1) & 1) * DA_BUF;
        const int knext = da_order(kt + 1 < 32 ? kt + 1 : 31, qt);
        if (kt + 1 < 32) {
#pragma unroll
            for (int j = 0; j < 2; ++j) { pk_[j] = *(const u32x4*)(kg + (size_t)(knext * 64 + j * 32) * 1536); pv_[j] = *(const u32x4*)(vg + (size_t)(knext * 64 + j * 32) * 1536); }
        }
        const float relq = (float)(qpos - ktile * 64 - quad * 4);
        attn_step2<8, 2>(lds + cb, DA_KSTR, lds + cb + DA_KB, DA_VSTR, qa0, qa1, qb0, qb1, oa, ob, ma, la, mb, lb, relq, nslope, tid);
        if (kt + 1 < 32) {
#pragma unroll
            for (int j = 0; j < 2; ++j) { *(LAS u32x4*)(lds + nb_ + (r0 + j * 32) * DA_KSTR + ch * 16) = pk_[j]; *(LAS u32x4*)(lds + nb_ + DA_KB + (r0 + j * 32) * DA_VSTR + ch * 16) = pv_[j]; }
        }
        ktile = knext;
        __syncthreads();
    }
    la += __shfl_xor(la, 16); la += __shfl_xor(la, 32); lb += __shfl_xor(lb, 16); lb += __shfl_xor(lb, 32);
    const float ila = frcp(la), ilb = lam * frcp(lb);
    float ss = 0.f;
#pragma unroll
    for (int d = 0; d < 8; ++d) { oa[d] = oa[d] * ila - ob[d] * ilb; ss += (oa[d][0] * oa[d][0] + oa[d][1] * oa[d][1]) + (oa[d][2] * oa[d][2] + oa[d][3] * oa[d][3]); }
    ss += __shfl_xor(ss, 16); ss += __shfl_xor(ss, 32);
    const float rn = oml / sqrtf(ss * (1.f / 128.f) + 1e-6f);
    bf16_t* yp = ya + (rb + qpos) * 1536 + h * 128 + quad * 4;
#pragma unroll
    for (int d = 0; d < 8; ++d) { const f32x4 g = *(const f32x4*)(subln + d * 16 + quad * 4); u32x2 w; w.x = pk2(oa[d][0] * rn * g[0], oa[d][1] * rn * g[1]); w.y = pk2(oa[d][2] * rn * g[2], oa[d][3] * rn * g[3]); *(u32x2*)(yp + d * 16) = w; }
}

constexpr int DL_STR = 144, DL_KB = 256 * DL_STR;
__device__ __forceinline__ void dil_unit(LAS unsigned char* lds, const bf16_t* zB, bf16_t* OP, float* LSE, int bl, int h, int pi, int su, float slope, int tid) {
    const int lane = tid & 63, wv = __builtin_amdgcn_readfirstlane(tid >> 6), fr = lane & 15, quad = lane >> 4;
    const int d = (pi == 0) ? 1 : ((pi == 1) ? 4 : 16), L = SEQ / d, nseg = L / 128;
    const size_t rb = (size_t)bl * SEQ;
    u32x4 kv_[4], vv_[4]; bf16x8 qn0, qn1;
#define DL_LOAD(S16) do { const int r_ = (S16) / nseg, m0_ = ((S16) % nseg) * 128; \
        _Pragma("unroll") for (int j = 0; j < 4; ++j) { const int id = tid + j * 512, row = id >> 3, ch = id & 7; int mk = m0_ - 64 + row; mk = mk < 0 ? 0 : (mk > L - 1 ? L - 1 : mk); \
            const bf16_t* src = zB + (rb + (size_t)(mk * d + r_)) * 1536 + h * 64 + ch * 8; kv_[j] = *(const u32x4*)(src + 512); vv_[j] = *(const u32x4*)(src + 1024); } \
        const bf16_t* qp_ = zB + (rb + (size_t)((m0_ + wv * 16 + fr) * d + r_)) * 1536 + h * 64 + quad * 8; qn0 = *(const bf16x8*)qp_; qn1 = *(const bf16x8*)(qp_ + 32); } while (0)
#define DL_STORE() do { _Pragma("unroll") for (int j = 0; j < 4; ++j) { const int id = tid + j * 512, row = id >> 3, ch = id & 7; \
            *(LAS u32x4*)(lds + row * DL_STR + ch * 16) = kv_[j]; *(LAS u32x4*)(lds + DL_KB + row * DL_STR + ch * 16) = vv_[j]; } } while (0)
    DL_LOAD(4 * su);
    DL_STORE();
    __syncthreads();
#pragma unroll 1
    for (int i = 0; i < 4; ++i) {
        const int s16 = 4 * su + i, r = s16 / nseg, m0 = (s16 % nseg) * 128;
        const bf16x8 q0 = qn0, q1 = qn1;
        if (i < 3) DL_LOAD(s16 + 1);
        f32x4 o[4];
#pragma unroll
        for (int t = 0; t < 4; ++t) o[t] = (f32x4){0.f, 0.f, 0.f, 0.f};
        float m = -1e30f, l = 0.f;
        const float relq = (float)(fr + 64 - quad * 4);
        const int kidx0 = m0 - 64 + wv * 16;
        if (kidx0 < 0 || kidx0 + 160 > L)
            attn_step<4, 5, true, true>(lds + (wv * 16) * DL_STR, DL_STR, lds + DL_KB + (wv * 16) * DL_STR, DL_STR, q0, q1, o, m, l, relq, -slope * LOG2E * (float)d, kidx0, L, tid);
        else
            attn_step<4, 5, true, false>(lds + (wv * 16) * DL_STR, DL_STR, lds + DL_KB + (wv * 16) * DL_STR, DL_STR, q0, q1, o, m, l, relq, -slope * LOG2E * (float)d, kidx0, L, tid);
        l += __shfl_xor(l, 16); l += __shfl_xor(l, 32);
        const float il = frcp(l);
        const size_t qrow = rb + (size_t)((m0 + wv * 16 + fr) * d + r);
        bf16_t* op = OP + ((size_t)pi * MH + qrow) * 512 + h * 64 + quad * 4;
#pragma unroll
        for (int t = 0; t < 4; ++t) { u32x2 w; w.x = pk2(o[t][0] * il, o[t][1] * il); w.y = pk2(o[t][2] * il, o[t][3] * il); *(u32x2*)(op + t * 16) = w; }
        if (quad == 0) LSE[((size_t)pi * MH + qrow) * 8 + h] = m + flog2(l);
        if (i < 3) { __syncthreads(); DL_STORE(); __syncthreads(); }
    }
#undef DL_LOAD
#undef DL_STORE
}

constexpr int HG_QE = 0, HG_KN = 17408, HG_KET = 34816, HG_VV = 53248, HG_STB = 71680, HG_EBT = 106496, HG_SUB = 107008;
__device__ __forceinline__ int hg_row(int bl, int dir, int c, int t) { const int s = c * 64 + t; return bl * SEQ + (dir ? (SEQ - 1 - s) : s); }
__device__ __forceinline__ void hgrn_unit(LAS unsigned char* lds, bf16_t* zC, int bl, int h, int dir, float lb, int tid, bf16_t* ob, int ostr, int ocol) {
    const int lane = tid & 63, wv = __builtin_amdgcn_readfirstlane(tid >> 6), fr = lane & 15, quad = lane >> 4;
    const int k = tid & 127, tq = tid >> 7;
    const float oml = 1.f - lb;
    const int fcol = 512 + dir * 512 + h * 128;
    f32x4 st[8];
#pragma unroll
    for (int i = 0; i < 8; ++i) st[i] = (f32x4){0.f, 0.f, 0.f, 0.f};
    u32x4 vp_[2], qp_[2], fp_[2];
#define HG_PREFETCH(C) do { _Pragma("unroll") for (int j = 0; j < 2; ++j) { const int id = tid + j * 512; const bf16_t* rp_ = zC + (size_t)hg_row(bl, dir, (C), id >> 4) * 2560 + h * 128 + (id & 15) * 8; \
        qp_[j] = *(const u32x4*)rp_; fp_[j] = *(const u32x4*)(rp_ + fcol - h * 128); vp_[j] = *(const u32x4*)(rp_ + 1536); } } while (0)
    HG_PREFETCH(0);
    for (int c = 0; c < 32; ++c) {
#pragma unroll
        for (int j = 0; j < 2; ++j) { const int id = tid + j * 512; *(LAS u32x4*)(lds + HG_QE + (id >> 4) * 272 + (id & 15) * 16) = qp_[j]; *(LAS u32x4*)(lds + HG_KN + (id >> 4) * 272 + (id & 15) * 16) = fp_[j];
            *(LAS u32x4*)(lds + HG_VV + (id >> 4) * 288 + (id & 15) * 16) = vp_[j]; }
        __syncthreads();
        float bl_[16], kk_[16]; float run = 0.f;
#pragma unroll
        for (int i = 0; i < 16; ++i) {
            const float f = bf2f(*(const LAS unsigned short*)(lds + HG_KN + (tq * 16 + i) * 272 + k * 2));
            const float sg = frcp(1.f + fexp2(-LOG2E * f));
            const float fg = lb + oml * sg;
            const float g2 = fmaxf(flog2(fg), -100.f);
            run += g2; bl_[i] = run; kk_[i] = oml * (1.f - sg);
        }
        ((LAS float*)(lds + HG_SUB))[tq * 128 + k] = run;
#pragma unroll
        for (int kt = 0; kt < 8; ++kt)
#pragma unroll
            for (int j = 0; j < 4; ++j) *(LAS unsigned short*)(lds + HG_STB + (wv * 16 + quad * 4 + j) * 272 + (kt * 16 + fr) * 2) = f2bf(st[kt][j]);
        __syncthreads();
        {
            const LAS float* SUB = (const LAS float*)(lds + HG_SUB);
            const float s0 = SUB[k], s1 = SUB[128 + k], s2 = SUB[256 + k], s3 = SUB[384 + k];
            const float bn = (tq > 0 ? s0 : 0.f) + (tq > 1 ? s1 : 0.f) + (tq > 2 ? s2 : 0.f);
            const float btot = (s0 + s1) + (s2 + s3);
            float ke_[16];
#pragma unroll
            for (int i = 0; i < 16; ++i) {
                const float bc = bn + bl_[i];
                const float q = bf2f(*(const LAS unsigned short*)(lds + HG_QE + (tq * 16 + i) * 272 + k * 2));
                const float qe = q * fexp2(bc);
                const float kn = kk_[i] * fexp2(fminf(-bc, 110.f));
                ke_[i] = kk_[i] * fexp2(btot - bc);
                *(LAS unsigned short*)(lds + HG_QE + (tq * 16 + i) * 272 + k * 2) = f2bf(qe);
                *(LAS unsigned short*)(lds + HG_KN + (tq * 16 + i) * 272 + k * 2) = f2bf(kn);
            }
            u32x4 w0, w1;
            w0.x = pk2(ke_[0], ke_[1]); w0.y = pk2(ke_[2], ke_[3]); w0.z = pk2(ke_[4], ke_[5]); w0.w = pk2(ke_[6], ke_[7]);
            w1.x = pk2(ke_[8], ke_[9]); w1.y = pk2(ke_[10], ke_[11]); w1.z = pk2(ke_[12], ke_[13]); w1.w = pk2(ke_[14], ke_[15]);
            *(LAS u32x4*)(lds + HG_KET + k * 144 + tq * 32) = w0; *(LAS u32x4*)(lds + HG_KET + k * 144 + tq * 32 + 16) = w1;
            if (tq == 0) ((LAS float*)(lds + HG_EBT))[k] = fexp2(btot);
        }
        __syncthreads();
        if (c + 1 < 32) HG_PREFETCH(c + 1);
        f32x4 o[4];
#pragma unroll
        for (int tt = 0; tt < 4; ++tt) o[tt] = (f32x4){0.f, 0.f, 0.f, 0.f};
#pragma unroll
        for (int sb = 0; sb < 2; ++sb) {
            f32x4 at[2][4];
#pragma unroll
            for (int ts = 0; ts < 2; ++ts)
#pragma unroll
                for (int tt = 0; tt < 4; ++tt) at[ts][tt] = (f32x4){0.f, 0.f, 0.f, 0.f};
#pragma unroll
            for (int ks = 0; ks < 4; ++ks) {
                bf16x8 qf[4];
#pragma unroll
                for (int tt = 0; tt < 4; ++tt) if (tt >= 2 * sb) qf[tt] = *(const LAS bf16x8*)(lds + HG_QE + (tt * 16 + fr) * 272 + (ks * 32 + quad * 8) * 2);
                if (sb == 0) {
                    const bf16x8 sa = *(const LAS bf16x8*)(lds + HG_STB + (wv * 16 + fr) * 272 + (ks * 32 + quad * 8) * 2);
#pragma unroll
                    for (int tt = 0; tt < 4; ++tt) o[tt] = mfma16(sa, qf[tt], o[tt]);
                }
#pragma unroll
                for (int ts = 0; ts < 2; ++ts) {
                    const int a = sb * 2 + ts;
                    const bf16x8 kf = *(const LAS bf16x8*)(lds + HG_KN + (a * 16 + fr) * 272 + (ks * 32 + quad * 8) * 2);
#pragma unroll
                    for (int tt = 0; tt < 4; ++tt) if (tt >= a) at[ts][tt] = mfma16(kf, qf[tt], at[ts][tt]);
                }
            }
#pragma unroll
            for (int ts = 0; ts < 2; ++ts)
#pragma unroll
                for (int j = 0; j < 4; ++j) at[ts][sb * 2 + ts][j] = (quad * 4 + j > fr) ? 0.f : at[ts][sb * 2 + ts][j];
            const LAS unsigned char* vp = lds + HG_VV + (sb * 32 + quad * 4 + (fr >> 2)) * 288 + (wv * 16 + (fr & 3) * 4) * 2;
            const bf16x8 vf = cat8(ldtr(vp), ldtr(vp + 16 * 288));
#pragma unroll
            for (int tt = 0; tt < 4; ++tt) if (tt >= 2 * sb) o[tt] = mfma16(vf, pack8(at[0][tt], at[1][tt]), o[tt]);
        }
#pragma unroll
        for (int kt = 0; kt < 8; ++kt) { const float eb = ((const LAS float*)(lds + HG_EBT))[kt * 16 + fr]; st[kt] = st[kt] * eb; }
#pragma unroll
        for (int tb = 0; tb < 2; ++tb) {
            const LAS unsigned char* vp = lds + HG_VV + (tb * 32 + quad * 8 + (fr >> 2)) * 288 + (wv * 16 + (fr & 3) * 4) * 2;
            const bf16x8 vf = cat8(ldtr(vp), ldtr(vp + 4 * 288));
#pragma unroll
            for (int kt = 0; kt < 8; ++kt) { const bf16x8 kb = *(const LAS bf16x8*)(lds + HG_KET + (kt * 16 + fr) * 144 + (tb * 32 + quad * 8) * 2); st[kt] = mfma16(vf, kb, st[kt]); }
        }
#pragma unroll
        for (int tt = 0; tt < 4; ++tt) { u32x2 w; w.x = pk2(o[tt][0], o[tt][1]); w.y = pk2(o[tt][2], o[tt][3]);
            *(u32x2*)(ob + (size_t)hg_row(bl, dir, c, tt * 16 + fr) * ostr + ocol + wv * 16 + quad * 4) = w; }
        __syncthreads();
    }
#undef HG_PREFETCH
}

__device__ __forceinline__ void post_rows(const bf16_t* OP, const float* LSE, const bf16_t* zC, bf16_t* yb, bf16_t* yc, const float* hnorm, int tid, int bid, int nbk) {
    const int lane = tid & 63, wv = tid >> 6;
    const int gw = bid * 8 + wv, NGW = nbk * 8;
    for (int r = gw; r < MH; r += NGW) {
        {
            const int hb = lane >> 3;
            const float l0 = LSE[((size_t)0 * MH + r) * 8 + hb], l1 = LSE[((size_t)1 * MH + r) * 8 + hb], l2 = LSE[((size_t)2 * MH + r) * 8 + hb];
            const float mx = fmaxf(l0, fmaxf(l1, l2));
            float w0 = fexp2(l0 - mx), w1 = fexp2(l1 - mx), w2 = fexp2(l2 - mx);
            const float iw = frcp(w0 + w1 + w2); w0 *= iw; w1 *= iw; w2 *= iw;
            const u32x4 a = *(const u32x4*)(OP + ((size_t)0 * MH + r) * 512 + lane * 8), b = *(const u32x4*)(OP + ((size_t)1 * MH + r) * 512 + lane * 8), c = *(const u32x4*)(OP + ((size_t)2 * MH + r) * 512 + lane * 8);
            u32x4 o;
            o.x = pk2(w0 * bflo(a.x) + w1 * bflo(b.x) + w2 * bflo(c.x), w0 * bfhi(a.x) + w1 * bfhi(b.x) + w2 * bfhi(c.x));
            o.y = pk2(w0 * bflo(a.y) + w1 * bflo(b.y) + w2 * bflo(c.y), w0 * bfhi(a.y) + w1 * bfhi(b.y) + w2 * bfhi(c.y));
            o.z = pk2(w0 * bflo(a.z) + w1 * bflo(b.z) + w2 * bflo(c.z), w0 * bfhi(a.z) + w1 * bfhi(b.z) + w2 * bfhi(c.z));
            o.w = pk2(w0 * bflo(a.w) + w1 * bflo(b.w) + w2 * bflo(c.w), w0 * bfhi(a.w) + w1 * bfhi(b.w) + w2 * bfhi(c.w));
            *(u32x4*)(yb + (size_t)r * 1536 + lane * 8) = o;
        }
        {
            const bf16_t* zr = zC + (size_t)r * 2560 + lane * 8;
            const u32x4 a = *(const u32x4*)(zr + 512), b = *(const u32x4*)(zr + 1024), g = *(const u32x4*)(zr + 2048);
            float s[8], og[8];
            s[0] = bflo(a.x) + bflo(b.x); s[1] = bfhi(a.x) + bfhi(b.x); s[2] = bflo(a.y) + bflo(b.y); s[3] = bfhi(a.y) + bfhi(b.y);
            s[4] = bflo(a.z) + bflo(b.z); s[5] = bfhi(a.z) + bfhi(b.z); s[6] = bflo(a.w) + bflo(b.w); s[7] = bfhi(a.w) + bfhi(b.w);
            og[0] = bflo(g.x); og[1] = bfhi(g.x); og[2] = bflo(g.y); og[3] = bfhi(g.y); og[4] = bflo(g.z); og[5] = bfhi(g.z); og[6] = bflo(g.w); og[7] = bfhi(g.w);
            float ss = 0.f;
#pragma unroll
            for (int i = 0; i < 8; ++i) ss += s[i] * s[i];
            ss += __shfl_xor(ss, 1); ss += __shfl_xor(ss, 2); ss += __shfl_xor(ss, 4); ss += __shfl_xor(ss, 8);
            const float rn = 1.0f / sqrtf(ss * (1.f / 128.f) + 1e-6f);
            const float* gn = hnorm + (lane & 15) * 8;
            float y[8];
#pragma unroll
            for (int i = 0; i < 8; ++i) y[i] = s[i] * rn * gn[i] * siluf_(og[i]);
            u32x4 o; o.x = pk2(y[0], y[1]); o.y = pk2(y[2], y[3]); o.z = pk2(y[4], y[5]); o.w = pk2(y[6], y[7]);
            *(u32x4*)(yc + (size_t)r * 1536 + lane * 8) = o;
        }
    }
}

#define XB_TMO      128
#define XB_XCNT(j)  (256  + 64 * (j))
#define XB_XSUB(j)  (1280 + 64 * (j))
#define XB_XGEN(j)  (2304 + 64 * (j))
#define XB_TOP      3328
#define XB_TOPGEN   3392
#define XCD_BAR_WORDS 3456
#define XB_SPIN_CAP (1u << 18)

__device__ __forceinline__ unsigned xb_ld(unsigned* p)              { return __hip_atomic_load(p, __ATOMIC_RELAXED, __HIP_MEMORY_SCOPE_AGENT); }
__device__ __forceinline__ unsigned xb_add(unsigned* p, unsigned v) { return __hip_atomic_fetch_add(p, v, __ATOMIC_RELAXED, __HIP_MEMORY_SCOPE_AGENT); }
__device__ __forceinline__ unsigned xb_xcc_id() { return (unsigned)__builtin_amdgcn_s_getreg((3 << 11) | 20) & 0xFu; }
#define XB_SPIN(cond, bar) do { unsigned _sp = 0; while (cond) { __builtin_amdgcn_s_sleep(1); \
    if ((++_sp & 255u) == 0u) { if (xb_ld(&(bar)[XB_TMO])) break; if (_sp > XB_SPIN_CAP) { atomicAdd(&(bar)[XB_TMO], 1u); break; } } } } while (0)

struct XcdBarrier {
    unsigned* bar; unsigned x;
    volatile LAS unsigned* st;
};

__device__ __forceinline__ XcdBarrier xcd_barrier_post(unsigned* bar, volatile LAS unsigned* st) {
    XcdBarrier b; b.bar = bar; b.x = xb_xcc_id(); b.st = st;
    if (threadIdx.x == 0) (void)xb_add(&bar[XB_XCNT(b.x)], 1u);
    return b;
}
__device__ __forceinline__ void xcd_barrier_complete(unsigned* bar, unsigned x, unsigned& nloc, unsigned& nx) {
    const unsigned G = gridDim.x * gridDim.y * gridDim.z;
    unsigned sum, cnt, mine, sp = 0u;
    for (;;) {
        sum = 0u; cnt = 0u; mine = 0u;
#pragma unroll
        for (unsigned j = 0; j < 16; ++j) { const unsigned c = xb_ld(&bar[XB_XCNT(j)]); sum += c; cnt += (c > 0u) ? 1u : 0u; mine = (j == x) ? c : mine; }
        if (sum == G) break;
        __builtin_amdgcn_s_sleep(1);
        if ((++sp & 255u) == 0u) { if (xb_ld(&bar[XB_TMO])) break; if (sp > XB_SPIN_CAP) { atomicAdd(&bar[XB_TMO], 1u); break; } }
    }
    nloc = mine > 0u ? mine : 1u; nx = cnt > 0u ? cnt : 1u;
}

__device__ __forceinline__ void xcd_barrier(const XcdBarrier& b) {
    asm volatile("s_waitcnt vmcnt(0)" ::: "memory");
    __syncthreads();
    if (threadIdx.x == 0) {
        unsigned* bar = b.bar;
        __builtin_amdgcn_s_waitcnt(0);
        unsigned nloc = b.st[0], nx = b.st[1];
        if (nloc == 0u) { xcd_barrier_complete(bar, b.x, nloc, nx); b.st[0] = nloc; b.st[1] = nx; }
        const unsigned old = xb_add(&bar[XB_XSUB(b.x)], 1u);
        const unsigned gen = old / nloc;
        if (old + 1u == (gen + 1u) * nloc) {
            __builtin_amdgcn_fence(__ATOMIC_RELEASE, "agent");
            asm volatile("s_waitcnt vmcnt(0)" ::: "memory");
            const unsigned og = xb_add(&bar[XB_TOP], 1u);
            const unsigned tg = og / nx;
            if (og + 1u == (tg + 1u) * nx) xb_add(&bar[XB_TOPGEN], 1u);
            else XB_SPIN(xb_ld(&bar[XB_TOPGEN]) == tg, bar);
            __builtin_amdgcn_fence(__ATOMIC_ACQUIRE, "agent");
            xb_add(&bar[XB_XGEN(b.x)], 1u);
            asm volatile("s_waitcnt vmcnt(0)" ::: "memory");
        } else {
            XB_SPIN(xb_ld(&bar[XB_XGEN(b.x)]) == gen, bar);
            __builtin_amdgcn_fence(__ATOMIC_ACQUIRE, "agent");
            asm volatile("s_waitcnt vmcnt(0)" ::: "memory");
        }
    }
    __syncthreads();
}

template <class Epi>
__device__ __forceinline__ void run_gemm(LAS unsigned char* lds, const bf16_t* A, const bf16_t* Bt, int M, int N, int K, const Epi& E, int bid, int nbk) {
    pg8::Gemm g{A, Bt, M, N, K}; pg8::StaticOrder S; S.init(M, N, nbk, bid);
    pg8::gemm_phase<Epi, pg8::StaticOrder, true, true>(lds, g, S, E);
}

__global__ void __launch_bounds__(512, 2) mega_fwd(Args a) {
    extern __shared__ __attribute__((aligned(16))) unsigned char lds_raw[];
    LAS unsigned char* lds = (LAS unsigned char*)lds_raw;
    cg::grid_group grid = cg::this_grid();
    if (threadIdx.x < 4) ((LAS unsigned*)(lds + LDS_CTRL + 64))[threadIdx.x] = 0u;
    __syncthreads();
    const XcdBarrier xbar = xcd_barrier_post((unsigned*)(a.ws + WS_CTL) + CW_BAR, (volatile LAS unsigned*)(lds + LDS_CTRL + 64));
    const int ph_lo = a.ph_lo, ph_hi = a.ph_hi;
#pragma unroll 1
    for (int ph = ph_lo; ph < ph_hi; ++ph) {
    ArgP ap = (ArgP)__builtin_amdgcn_kernarg_segment_ptr(); asm volatile("" : "+s"(ap));
    int tid = threadIdx.x; asm volatile("" : "+v"(tid));
    int bid = blockIdx.x; asm volatile("" : "+s"(bid));
    int nbk = gridDim.x; asm volatile("" : "+s"(nbk));
    unsigned char* ws = ap->ws;
    unsigned char* wb = ws + WS_W;
    bf16_t* xn = (bf16_t*)(ws + WS_XN);
    bf16_t* act = (bf16_t*)(ws + WS_BIG);
    bf16_t *zA = (bf16_t*)(ws + WS_ZA), *zB = (bf16_t*)(ws + WS_ZB), *zC = (bf16_t*)(ws + WS_ZC), *zG = (bf16_t*)(ws + WS_ZG);
    float* mF = (float*)(ws + WS_MF); bf16_t* mB = (bf16_t*)(ws + WS_MB);
    bf16_t *ya = (bf16_t*)(ws + WS_YA), *yb = ya + 512, *yc = ya + 1024, *OP = (bf16_t*)(ws + WS_OP);
    float* LSE = (float*)(ws + WS_LSE);
    unsigned* RS = (unsigned*)(ws + WS_RS);
    const float* x = ap->in[0]; float* out = ap->out;

        if (ph == NPH - 1) {
            final_norm_rows(xn, out, ap->in[22], tid, bid, nbk);
        } else {
            const int l = ph / 17, r = ph % 17;
            if (r == 0) {
                prep_weights(ap, l, lds, tid, bid * 8 + (tid >> 6), nbk * 8, 0, PREP_EARLY);
                if (l == 0) norm_rows(x, xn, nullptr, nullptr, RS, tid, bid, nbk);
            } else if (r == 1 || r == 15) {
                pg8::EpiGU E{act, DFF, RS + (size_t)(l * 3 + (r == 1 ? 0 : 2)) * MTOK};
                run_gemm(lds, xn, (const bf16_t*)(wb + (r == 1 ? W_GU1 : W_GU2)), MTOK, 2 * DFF, DM, E, bid, nbk);
            } else if (r == 2 || r == 16) {
                pg8::EpiRes E{nullptr, xn, RS + (size_t)(r == 2 ? l * 3 + 1 : (l + 1) * 3) * MTOK, 1};
                run_gemm(lds, act, (const bf16_t*)(wb + (r == 2 ? W_D1 : W_D2)), MTOK, DM, DFF, E, bid, nbk);
            } else if (r == 3 || r == 14) {
                continue;
            } else {
                const int hs = (r - 4) / 5, kk = (r - 4) % 5;
                const size_t hrow0 = (size_t)hs * MH;
                if (kk == 0) {
                    pg8::EpiIn E{zA, zB, zC, zG, RS + (size_t)(l * 3 + 1) * MTOK + hrow0};
                    run_gemm(lds, xn + hrow0 * DM, (const bf16_t*)(wb + W_IN), MH, DIN, DM, E, bid, nbk);
                    if (hs == 0) {
                        const int nwg = (MH / 256) * (DIN / 256), first = nwg % nbk, nidle = nbk - first;
                        if (bid >= first) prep_weights(ap, l, lds, tid, (bid - first) * 8 + (tid >> 6), nidle * 8, PREP_EARLY, PREP_NIT);
                    }
                } else if (kk == 1) {
                    unsigned* counter = (unsigned*)(ws + WS_CTL) + 64 * (l * 2 + hs);
                    LAS int* shu = (LAS int*)(lds + LDS_CTRL);
                    const float lam_init = 0.8f - 0.6f * expf(-0.3f * (float)l);
                    float lam;
                    {
                        const int lane = tid & 63;
                        const float p1 = ap->in[7][l * 64 + lane] * ap->in[8][l * 64 + lane], p2 = ap->in[9][l * 64 + lane] * ap->in[10][l * 64 + lane];
                        lam = expf(wave_sum(p1)) - expf(wave_sum(p2)) + lam_init;
                    }
                    for (;;) {
                        __syncthreads();
                        if (tid == 0) *shu = (int)atomicAdd(counter, 1u);
                        __syncthreads();
                        const int u = *shu;
                        if (u >= NU_ALL + PROBE_DUP_H * NU_H + PROBE_DUP_A * (NU_D + NU_L)) break;
                        int tidu = tid; asm volatile("" : "+v"(tidu));
                        int u2 = u;
#if PROBE_DUP_H
                        const bool dummy = u2 < NU_H; if (!dummy) u2 -= NU_H;
#else
                        const bool dummy = false;
#endif
#if PROBE_DUP_A
                        if (u2 >= NU_ALL) u2 -= (NU_D + NU_L);
#endif
                        if (dummy || u2 < NU_H) {
                            const int dir = u2 & 1, h = (u2 >> 1) & 3, bl = u2 >> 3;
                            float lb = 0.f;
                            if (l == 1) { const int k = tidu & 127; const float x0 = ap->in[12][h * 128 + k], x1 = ap->in[12][512 + h * 128 + k]; const float mx = fmaxf(x0, x1); const float e0 = expf(x0 - mx), e1 = expf(x1 - mx); lb = e1 / (e0 + e1); }
                            if (dummy) hgrn_unit(lds, zC, bl, h, dir, lb, tidu, OP, 1024, dir * 512 + h * 128);
                            else hgrn_unit(lds, zC, bl, h, dir, lb, tidu, zC, 2560, 512 + dir * 512 + h * 128);
                        } else if (u2 < NU_H + NU_D) {
                            const int v = u2 - NU_H, qt = v & 15, h = (v >> 4) & 3, bl = v >> 6;
                            const float slope = exp2f(-8.0f * (float)(3 * h + 1) / 12.0f);
                            diff_unit(lds, zA, ya, bl, h, qt, slope, lam, 1.f - lam_init, ap->in[11] + l * 128, tidu);
                        } else {
                            const int v = u2 - NU_H - NU_D, s16 = v & 3, t = v >> 2, pi = t % 3, t2 = t / 3, h = t2 & 7, bl = t2 >> 3;
                            const int aidx = h + 1 + (h >> 1);
                            const float slope = exp2f(-8.0f * (float)(aidx + 1) / 12.0f);
                            dil_unit(lds, zB, OP, LSE, bl, h, pi, s16, slope, tidu);
                        }
                    }
                } else if (kk == 2) {
                    post_rows(OP, LSE, zC, yb, yc, ap->in[13] + l * 128, tid, bid, nbk);
                } else if (kk == 3) {
                    pg8::EpiBr E{zG, mB};
                    run_gemm(lds, ya, (const bf16_t*)(wb + W_BA), MH, DM, 1536, E, bid, nbk);
                } else {
                    pg8::EpiRes E{nullptr, xn + hrow0 * DM, RS + (size_t)(l * 3 + 2) * MTOK + hrow0, 0};
                    run_gemm(lds, mB, (const bf16_t*)(wb + W_OUT), MH, DM, DM, E, bid, nbk);
                }
            }
        }
        if (ph + 1 < ph_hi) { if (ph == ph_lo) grid.sync(); else xcd_barrier(xbar); }
    }
}

#ifndef N_LAUNCH_SPLIT
#define N_LAUNCH_SPLIT 0
#endif
extern "C" void kernel_launch(void* const* d_in, const int* in_sizes, int n_in, void* d_out, int out_size, void* d_ws, size_t ws_size, hipStream_t stream) {
    static int grid = 0;
    if (grid == 0) {
        if (n_in != 23 || out_size != MTOK * DM || ws_size < WS_END) { fprintf(stderr, "kernel_launch: unexpected shapes (n_in %d out %d ws %zu)\n", n_in, out_size, ws_size); grid = -1; return; }
        int dev = 0, cus = 0, per_cu = 0;
        (void)hipGetDevice(&dev);
        (void)hipDeviceGetAttribute(&cus, hipDeviceAttributeMultiprocessorCount, dev);
        if (hipFuncSetAttribute((const void*)mega_fwd, hipFuncAttributeMaxDynamicSharedMemorySize, LDS_BYTES) != hipSuccess) { fprintf(stderr, "kernel_launch: hipFuncSetAttribute failed\n"); grid = -1; return; }
        if (hipOccupancyMaxActiveBlocksPerMultiprocessor(&per_cu, (const void*)mega_fwd, 512, LDS_BYTES) != hipSuccess || per_cu < 1) { fprintf(stderr, "kernel_launch: occupancy query says %d\n", per_cu); per_cu = 1; }
        (void)hipGetLastError();
        grid = cus * per_cu;
    }
    if (grid < 0) return;
    (void)hipMemsetAsync((char*)d_ws + WS_CTL, 0, CTL_BYTES, stream);
    Args a{};
    for (int i = 0; i < 23; ++i) a.in[i] = (const float*)d_in[i];
    a.out = (float*)d_out; a.ws = (unsigned char*)d_ws;
#if N_LAUNCH_SPLIT
    for (int p = 0; p < NPH; ++p) {
        a.ph_lo = p; a.ph_hi = p + 1;
        void* args[] = {&a};
        hipError_t e = hipLaunchCooperativeKernel((const void*)mega_fwd, dim3(grid), dim3(512), args, LDS_BYTES, stream);
        if (e != hipSuccess) { fprintf(stderr, "cooperative launch failed: %s (grid %d)\n", hipGetErrorString(e), grid); break; }
    }
#else
    a.ph_lo = 0; a.ph_hi = NPH;
    void* args[] = {&a};
    hipError_t e = hipLaunchCooperativeKernel((const void*)mega_fwd, dim3(grid), dim3(512), args, LDS_BYTES, stream);
    if (e != hipSuccess) fprintf(stderr, "cooperative launch failed: %s (grid %d)\n", hipGetErrorString(e), grid);
#endif
}
```
